# Optimizing an MI355X kernel written in HIP

```python
import jax, jax.numpy as jnp
from jax import lax
import numpy as np

D_MODEL = 1024
BATCH = 1
SEQ = 16384
DEPTH = 2

N_A = DEPTH // 2
N_B = DEPTH - N_A
HEAD_DIM = 64
MIX_HEADS = 12
MIX_WIDTH = MIX_HEADS * HEAD_DIM
MEM_HEADS = 4
MEM_WIDTH = MEM_HEADS * HEAD_DIM
MEM_TOKENS = 256
D_FF = 2752
DECAY_LORA = 64
AAA_LORA = 64
GATE_LORA = 128
SHIFT_WIDTH = 3 * MIX_WIDTH + DECAY_LORA + AAA_LORA + GATE_LORA
A_IN_WIDTH = SHIFT_WIDTH + MEM_WIDTH
B_IN_WIDTH = MIX_WIDTH + MEM_WIDTH
KV_WIDTH = 2 * MIX_WIDTH
MOBA_BLOCK = 256
MOBA_TOPK = 3
Q_CHUNK = 128
ALIBI_MAX = 8.0
NORM_EPS = 1e-6
GN_EPS = 64e-5

kernel_name = "yoco_rwkv7_moba_macaron_memory"


def rms_norm(x, g, eps=NORM_EPS):
    xf = x.astype(jnp.float32)
    y = xf * lax.rsqrt(jnp.mean(xf * xf, axis=-1, keepdims=True) + eps)
    return (y * g.astype(jnp.float32)).astype(x.dtype)


def swiglu_ffn(x, g, w1, w3, w2):
    h = rms_norm(x, g)
    return (jax.nn.silu(h @ w1) * (h @ w3)) @ w2


def rwkv7_mixer(u, mu, w0, w2, a0, a2, g2, k_k, k_a, r_k, ln_w, ln_b):
    B_, S_, _ = u.shape
    f32 = jnp.float32
    prev = jnp.pad(u[:, :-1], ((0, 0), (1, 0), (0, 0)))
    u = u + (prev - u) * mu
    cuts = [MIX_WIDTH, 2 * MIX_WIDTH, 3 * MIX_WIDTH,
            3 * MIX_WIDTH + DECAY_LORA, 3 * MIX_WIDTH + DECAY_LORA + AAA_LORA]
    r, k, v, wd, ad, gd = jnp.split(u, cuts, axis=-1)
    w_log = -jax.nn.softplus(-(w0 + jnp.tanh(wd) @ w2).astype(f32)) - 0.5
    decay = jnp.exp(-jnp.exp(w_log))
    a = jax.nn.sigmoid((a0 + ad @ a2).astype(f32))
    g = jax.nn.sigmoid(gd) @ g2

    def heads(t):
        return t.astype(f32).reshape(B_, S_, MIX_HEADS, HEAD_DIM)

    def per_head(p):
        return p.astype(f32).reshape(MIX_HEADS, HEAD_DIM)

    r, k, v, decay, a = heads(r), heads(k), heads(v), heads(decay), heads(a)
    kk = k * per_head(k_k)
    kk = kk / jnp.maximum(jnp.sqrt(jnp.sum(kk * kk, axis=-1, keepdims=True)), 1e-12)
    k = k * (1.0 + (a - 1.0) * per_head(k_a))
    b = kk * a

    def step(state, inp):
        r_t, w_t, k_t, v_t, kk_t, b_t = inp
        sa = jnp.einsum('bhvk,bhk->bhv', state, kk_t)
        state = (state * w_t[:, :, None, :] - sa[..., None] * b_t[:, :, None, :]
                 + v_t[..., None] * k_t[:, :, None, :])
        y_t = jnp.einsum('bhvk,bhk->bhv', state, r_t)
        return state, y_t

    xs = tuple(jnp.moveaxis(t, 1, 0) for t in (r, decay, k, v, kk, b))
    state0 = jnp.zeros((B_, MIX_HEADS, HEAD_DIM, HEAD_DIM), f32)
    _, y = lax.scan(step, state0, xs)
    y = jnp.moveaxis(y, 0, 1)
    mean = jnp.mean(y, axis=-1, keepdims=True)
    var = jnp.mean(jnp.square(y - mean), axis=-1, keepdims=True)
    y = ((y - mean) * lax.rsqrt(var + GN_EPS)).reshape(B_, S_, MIX_WIDTH)
    y = y * ln_w.astype(f32) + ln_b.astype(f32)
    bonus = jnp.sum(r * k * per_head(r_k), axis=-1, keepdims=True) * v
    y = (y + bonus.reshape(B_, S_, MIX_WIDTH)) * g.astype(f32)
    return y.astype(u.dtype)


def memory_attention(q, mem, mem_norm, w_mem_kv, q_norm, k_norm):
    B_, S_, _ = q.shape
    M_ = mem.shape[1]
    q = rms_norm(q.reshape(B_, S_, MEM_HEADS, HEAD_DIM), q_norm)
    kv = rms_norm(mem, mem_norm) @ w_mem_kv
    k, v = jnp.split(kv, [MEM_WIDTH], axis=-1)
    k = rms_norm(k.reshape(B_, M_, MEM_HEADS, HEAD_DIM), k_norm)
    v = v.reshape(B_, M_, MEM_HEADS, HEAD_DIM)
    s = jnp.einsum('bshd,bmhd->bhsm', q, k, preferred_element_type=jnp.float32) * (HEAD_DIM ** -0.5)
    p = jax.nn.softmax(s, axis=-1).astype(v.dtype)
    o = jnp.einsum('bhsm,bmhd->bshd', p, v)
    return o.reshape(B_, S_, MEM_WIDTH)


def shared_kv(x, kv_norm, w_kv, k_norm):
    B_, S_, _ = x.shape
    nb = -(-S_ // MOBA_BLOCK)
    pad = nb * MOBA_BLOCK - S_
    kv = rms_norm(x, kv_norm) @ w_kv
    k, v = jnp.split(kv, [MIX_WIDTH], axis=-1)
    k = rms_norm(k.reshape(B_, S_, MIX_HEADS, HEAD_DIM), k_norm)
    v = v.reshape(B_, S_, MIX_HEADS, HEAD_DIM)
    k = jnp.pad(k, ((0, 0), (0, pad), (0, 0), (0, 0)))
    v = jnp.pad(v, ((0, 0), (0, pad), (0, 0), (0, 0)))
    k_blocks = k.reshape(B_, nb, MOBA_BLOCK, MIX_HEADS, HEAD_DIM).transpose(0, 3, 1, 2, 4)
    v_blocks = v.reshape(B_, nb, MOBA_BLOCK, MIX_HEADS, HEAD_DIM).transpose(0, 3, 1, 2, 4)
    k_mean = jnp.mean(k_blocks.astype(jnp.float32), axis=3).astype(k.dtype)
    return k_blocks, v_blocks, k_mean


def moba_attention(q, k_blocks, v_blocks, k_mean, q_norm):
    B_, S_, _ = q.shape
    nb = k_mean.shape[2]
    nc = S_ // Q_CHUNK
    topk = min(MOBA_TOPK, nb)
    scale = HEAD_DIM ** -0.5
    q = rms_norm(q.reshape(B_, S_, MIX_HEADS, HEAD_DIM), q_norm)
    q_chunks = q.reshape(B_, nc, Q_CHUNK, MIX_HEADS, HEAD_DIM).transpose(1, 0, 3, 2, 4)
    slopes = jnp.exp2(-ALIBI_MAX * jnp.arange(1, MIX_HEADS + 1, dtype=jnp.float32) / MIX_HEADS)
    b_idx = jnp.arange(B_)[:, None, None, None]
    h_idx = jnp.arange(MIX_HEADS)[None, :, None, None]
    offs = jnp.arange(MOBA_BLOCK)

    def one_chunk(args):
        qc, c = args
        t = c * Q_CHUNK + jnp.arange(Q_CHUNK)
        i_blk = (c * Q_CHUNK) // MOBA_BLOCK
        gate = jnp.einsum('bhcd,bhnd->bhcn', qc, k_mean, preferred_element_type=jnp.float32)
        gate = jnp.where(jnp.arange(nb) < i_blk, gate, -jnp.inf)
        _, sel = lax.top_k(gate, topk)
        valid = sel < i_blk
        kg = k_blocks[b_idx, h_idx, sel]
        vg = v_blocks[b_idx, h_idx, sel]
        s_sel = jnp.einsum('bhcd,bhckjd->bhckj', qc, kg, preferred_element_type=jnp.float32) * scale
        dist_sel = t[None, None, :, None, None] - (sel[..., None] * MOBA_BLOCK + offs)
        s_sel = jnp.where(valid[..., None],
                          s_sel - slopes[None, :, None, None, None] * dist_sel, -jnp.inf)
        k_own = lax.dynamic_index_in_dim(k_blocks, i_blk, axis=2, keepdims=False)
        v_own = lax.dynamic_index_in_dim(v_blocks, i_blk, axis=2, keepdims=False)
        s_own = jnp.einsum('bhcd,bhjd->bhcj', qc, k_own, preferred_element_type=jnp.float32) * scale
        dist_own = t[:, None] - (i_blk * MOBA_BLOCK + offs)[None, :]
        s_own = jnp.where(dist_own[None, None] >= 0,
                          s_own - slopes[None, :, None, None] * dist_own[None, None], -jnp.inf)
        scores = jnp.concatenate(
            [s_sel.reshape(B_, MIX_HEADS, Q_CHUNK, topk * MOBA_BLOCK), s_own], axis=-1)
        p = jax.nn.softmax(scores, axis=-1).astype(v_blocks.dtype)
        p_sel = p[..., :topk * MOBA_BLOCK].reshape(B_, MIX_HEADS, Q_CHUNK, topk, MOBA_BLOCK)
        p_own = p[..., topk * MOBA_BLOCK:]
        return (jnp.einsum('bhckj,bhckjd->bhcd', p_sel, vg)
                + jnp.einsum('bhcj,bhjd->bhcd', p_own, v_own))

    out = lax.map(one_chunk, (q_chunks, jnp.arange(nc)))
    return out.transpose(1, 0, 3, 2, 4).reshape(B_, S_, MIX_WIDTH)


def setup_inputs(seed: int = 0) -> dict:
    key = jax.random.key(seed)
    keys = jax.random.split(key, 40)
    ks = iter([keys[i] for i in range(40)])
    f32 = jnp.float32

    def w(shape, fan_in, scale=1.0):
        return jax.random.normal(next(ks), shape, f32) * (scale * fan_in ** -0.5)

    def gain(shape):
        return 1.0 + 0.02 * jax.random.normal(next(ks), shape, f32)

    def small(shape, s):
        return s * jax.random.normal(next(ks), shape, f32)

    D, L = D_MODEL, DEPTH
    return {
        "x": jax.random.normal(next(ks), (BATCH, SEQ, D), f32),
        "mem": jax.random.normal(next(ks), (BATCH, MEM_TOKENS, D), f32),
        "ffn1_norm": gain((L, D)),
        "ffn1_w1": w((L, D, D_FF), D),
        "ffn1_w3": w((L, D, D_FF), D),
        "ffn1_w2": w((L, D_FF, D), D_FF),
        "mix_norm": gain((L, D)),
        "w_out": w((L, MIX_WIDTH + MEM_WIDTH, D), MIX_WIDTH + MEM_WIDTH),
        "mem_norm": gain((L, D)),
        "w_mem_kv": w((L, D, 2 * MEM_WIDTH), D),
        "mem_q_norm": gain((L, HEAD_DIM)),
        "mem_k_norm": gain((L, HEAD_DIM)),
        "ffn2_norm": gain((L, D)),
        "ffn2_w1": w((L, D, D_FF), D),
        "ffn2_w3": w((L, D, D_FF), D),
        "ffn2_w2": w((L, D_FF, D), D_FF),
        "rwkv_w_in": w((N_A, D, A_IN_WIDTH), D),
        "rwkv_mu": jax.random.uniform(next(ks), (N_A, SHIFT_WIDTH), f32),
        "rwkv_w0": jax.random.uniform(next(ks), (N_A, MIX_WIDTH), f32, -5.0, 0.0),
        "rwkv_w2": w((N_A, DECAY_LORA, MIX_WIDTH), DECAY_LORA, 0.5),
        "rwkv_a0": small((N_A, MIX_WIDTH), 0.5),
        "rwkv_a2": w((N_A, AAA_LORA, MIX_WIDTH), AAA_LORA, 0.5),
        "rwkv_g2": w((N_A, GATE_LORA, MIX_WIDTH), GATE_LORA),
        "rwkv_k_k": 0.85 + small((N_A, MIX_WIDTH), 0.05),
        "rwkv_k_a": 1.0 + small((N_A, MIX_WIDTH), 0.05),
        "rwkv_r_k": small((N_A, MIX_HEADS, HEAD_DIM), 0.1),
        "rwkv_ln_w": gain((N_A, MIX_WIDTH)),
        "rwkv_ln_b": small((N_A, MIX_WIDTH), 0.02),
        "kv_norm": gain((D,)),
        "w_kv": w((D, KV_WIDTH), D),
        "kv_k_norm": gain((HEAD_DIM,)),
        "moba_w_in": w((N_B, D, B_IN_WIDTH), D),
        "moba_q_norm": gain((N_B, HEAD_DIM)),
    }


def reference(x, mem, ffn1_norm, ffn1_w1, ffn1_w3, ffn1_w2, mix_norm, w_out,
              mem_norm, w_mem_kv, mem_q_norm, mem_k_norm,
              ffn2_norm, ffn2_w1, ffn2_w3, ffn2_w2,
              rwkv_w_in, rwkv_mu, rwkv_w0, rwkv_w2, rwkv_a0, rwkv_a2, rwkv_g2,
              rwkv_k_k, rwkv_k_a, rwkv_r_k, rwkv_ln_w, rwkv_ln_b,
              kv_norm, w_kv, kv_k_norm, moba_w_in, moba_q_norm):
    shared = None
    for l in range(DEPTH):
        x = x + 0.5 * swiglu_ffn(x, ffn1_norm[l], ffn1_w1[l], ffn1_w3[l], ffn1_w2[l])
        h = rms_norm(x, mix_norm[l])
        if l < N_A:
            proj = h @ rwkv_w_in[l]
            mix = rwkv7_mixer(proj[..., :SHIFT_WIDTH], rwkv_mu[l], rwkv_w0[l], rwkv_w2[l],
                              rwkv_a0[l], rwkv_a2[l], rwkv_g2[l], rwkv_k_k[l], rwkv_k_a[l],
                              rwkv_r_k[l], rwkv_ln_w[l], rwkv_ln_b[l])
            mem_q = proj[..., SHIFT_WIDTH:]
        else:
            j = l - N_A
            proj = h @ moba_w_in[j]
            k_blocks, v_blocks, k_mean = shared
            mix = moba_attention(proj[..., :MIX_WIDTH], k_blocks, v_blocks, k_mean, moba_q_norm[j])
            mem_q = proj[..., MIX_WIDTH:]
        mem_out = memory_attention(mem_q, mem, mem_norm[l], w_mem_kv[l], mem_q_norm[l], mem_k_norm[l])
        x = x + jnp.concatenate([mix, mem_out], axis=-1) @ w_out[l]
        x = x + 0.5 * swiglu_ffn(x, ffn2_norm[l], ffn2_w1[l], ffn2_w3[l], ffn2_w2[l])
        if l == N_A - 1:
            shared = shared_kv(x, kv_norm, w_kv, kv_k_norm)
    return x
```

```cpp
#include <hip/hip_runtime.h>
#include <cstdint>
#include <cstdio>
#include <cmath>

typedef unsigned short bf16_t;
__host__ __device__ __forceinline__ float bf2f(bf16_t b) { union { unsigned u; float f; } c; c.u = ((unsigned)b) << 16; return c.f; }
__host__ __device__ __forceinline__ bf16_t f2bf(float f) { union { unsigned u; float f; } c; c.f = f; const unsigned u = c.u; return (bf16_t)((u + 0x7fffu + ((u >> 16) & 1u)) >> 16); }
namespace nv {

__device__ __forceinline__ float wsum(float v) {
#pragma unroll
    for (int o = 1; o < 64; o <<= 1) v += __shfl_xor(v, o);
    return v;
}
__device__ __forceinline__ float wmax(float v) {
#pragma unroll
    for (int o = 1; o < 64; o <<= 1) v = fmaxf(v, __shfl_xor(v, o));
    return v;
}

__global__ __launch_bounds__(256) void k_rstd(const float* __restrict__ x, float* __restrict__ rstd, int M) {
    const int wid = threadIdx.x >> 6, lane = threadIdx.x & 63;
    const int m = blockIdx.x * 4 + wid;
    if (m >= M) return;
    const float4* xr = (const float4*)(x + (size_t)m * 1024);
    float s = 0.f;
#pragma unroll
    for (int j = 0; j < 4; ++j) { float4 v = xr[lane + 64 * j]; s += v.x * v.x + v.y * v.y + v.z * v.z + v.w * v.w; }
    s = wsum(s);
    if (lane == 0) rstd[m] = rsqrtf(s * (1.f / 1024.f) + 1e-6f);
}

__device__ __forceinline__ int pcol_l1(int src) { return src < 768 ? src : (src < 2560 ? src + 256 : src - 2560 + 768); }

template <int MODE, bool ABF>
__global__ __launch_bounds__(256) void k_gemm(const void* __restrict__ Av, int lda, const float* __restrict__ rstd, const float* __restrict__ gain,
                                              const float* __restrict__ W, const float* __restrict__ W3, int N, int K,
                                              void* outv, int ldc, const float* res, float scale) {
    __shared__ float As[16][132];
    __shared__ float Bs[16][132];
    __shared__ float B3s[16][132];
    const int tid = threadIdx.x, tx = tid & 15, ty = tid >> 4;
    const int m0 = blockIdx.y * 128, n0 = blockIdx.x * 128;
    float acc[8][8], acc3[8][8];
#pragma unroll
    for (int i = 0; i < 8; ++i)
#pragma unroll
        for (int j = 0; j < 8; ++j) { acc[i][j] = 0.f; acc3[i][j] = 0.f; }
    const int ar = tid >> 1, akk = (tid & 1) * 8;
    const float rs = rstd ? rstd[m0 + ar] : 1.f;
    const int bk = tid >> 4, bn = (tid & 15) * 8;
    for (int k0 = 0; k0 < K; k0 += 16) {
        float v0, v1, v2, v3, v4, v5, v6, v7;
        if (ABF) {
            const bf16_t* A = (const bf16_t*)Av;
            const uint4 raw = *(const uint4*)(A + (size_t)(m0 + ar) * lda + k0 + akk);
            v0 = __uint_as_float(raw.x << 16); v1 = __uint_as_float(raw.x & 0xffff0000u);
            v2 = __uint_as_float(raw.y << 16); v3 = __uint_as_float(raw.y & 0xffff0000u);
            v4 = __uint_as_float(raw.z << 16); v5 = __uint_as_float(raw.z & 0xffff0000u);
            v6 = __uint_as_float(raw.w << 16); v7 = __uint_as_float(raw.w & 0xffff0000u);
        } else {
            const float* A = (const float*)Av;
            const float4 a0 = *(const float4*)(A + (size_t)(m0 + ar) * lda + k0 + akk);
            const float4 a1 = *(const float4*)(A + (size_t)(m0 + ar) * lda + k0 + akk + 4);
            v0 = a0.x; v1 = a0.y; v2 = a0.z; v3 = a0.w; v4 = a1.x; v5 = a1.y; v6 = a1.z; v7 = a1.w;
        }
        {
            float4 g0 = make_float4(1.f, 1.f, 1.f, 1.f), g1 = g0;
            if (gain) { g0 = *(const float4*)(gain + k0 + akk); g1 = *(const float4*)(gain + k0 + akk + 4); }
            As[akk + 0][ar] = v0 * rs * g0.x; As[akk + 1][ar] = v1 * rs * g0.y; As[akk + 2][ar] = v2 * rs * g0.z; As[akk + 3][ar] = v3 * rs * g0.w;
            As[akk + 4][ar] = v4 * rs * g1.x; As[akk + 5][ar] = v5 * rs * g1.y; As[akk + 6][ar] = v6 * rs * g1.z; As[akk + 7][ar] = v7 * rs * g1.w;
        }
        {
            const bool inb = (n0 + bn) < N;
            float4 b0 = make_float4(0.f, 0.f, 0.f, 0.f), b1 = b0, c0 = b0, c1 = b0;
            if (inb) {
                b0 = *(const float4*)(W + (size_t)(k0 + bk) * N + n0 + bn);
                b1 = *(const float4*)(W + (size_t)(k0 + bk) * N + n0 + bn + 4);
                if (MODE == 2) {
                    c0 = *(const float4*)(W3 + (size_t)(k0 + bk) * N + n0 + bn);
                    c1 = *(const float4*)(W3 + (size_t)(k0 + bk) * N + n0 + bn + 4);
                }
            }
            *(float4*)&Bs[bk][bn] = b0; *(float4*)&Bs[bk][bn + 4] = b1;
            if (MODE == 2) { *(float4*)&B3s[bk][bn] = c0; *(float4*)&B3s[bk][bn + 4] = c1; }
        }
        __syncthreads();
#pragma unroll
        for (int k = 0; k < 16; ++k) {
            float a[8], b[8], b3[8];
#pragma unroll
            for (int i = 0; i < 8; ++i) a[i] = As[k][ty + 16 * i];
            const float4 q0 = *(const float4*)&Bs[k][tx * 4], q1 = *(const float4*)&Bs[k][64 + tx * 4];
            b[0] = q0.x; b[1] = q0.y; b[2] = q0.z; b[3] = q0.w; b[4] = q1.x; b[5] = q1.y; b[6] = q1.z; b[7] = q1.w;
            if (MODE == 2) {
                const float4 p0 = *(const float4*)&B3s[k][tx * 4], p1 = *(const float4*)&B3s[k][64 + tx * 4];
                b3[0] = p0.x; b3[1] = p0.y; b3[2] = p0.z; b3[3] = p0.w; b3[4] = p1.x; b3[5] = p1.y; b3[6] = p1.z; b3[7] = p1.w;
            }
#pragma unroll
            for (int i = 0; i < 8; ++i)
#pragma unroll
                for (int j = 0; j < 8; ++j) { acc[i][j] = fmaf(a[i], b[j], acc[i][j]); if (MODE == 2) acc3[i][j] = fmaf(a[i], b3[j], acc3[i][j]); }
        }
        __syncthreads();
    }
#pragma unroll
    for (int i = 0; i < 8; ++i) {
        const int row = m0 + ty + 16 * i;
#pragma unroll
        for (int j = 0; j < 8; ++j) {
            const int col = n0 + tx * 4 + 64 * (j >> 2) + (j & 3);
            const float a = acc[i][j];
            if (col < N) {
            if (MODE == 0) ((float*)outv)[(size_t)row * ldc + col] = a;
            else if (MODE == 1) ((bf16_t*)outv)[(size_t)row * ldc + pcol_l1(col)] = f2bf(a);
            else if (MODE == 2) { const float b = acc3[i][j]; ((float*)outv)[(size_t)row * ldc + col] = (a / (1.f + __expf(-a))) * b; }
            else if (MODE == 3) ((float*)outv)[(size_t)row * ldc + col] = res[(size_t)row * ldc + col] + scale * a;
            else ((bf16_t*)outv)[(size_t)row * ldc + col] = f2bf(a);
            }
        }
    }
}

template <typename T>
__global__ __launch_bounds__(256) void k_headnorm(T* buf, int ld, int col0, int H, const float* __restrict__ gain, int rows) {
    const int wid = threadIdx.x >> 6, lane = threadIdx.x & 63;
    const int idx = blockIdx.x * 4 + wid;
    if (idx >= rows * H) return;
    const int r = idx / H, h = idx % H;
    T* p = buf + (size_t)r * ld + col0 + h * 64 + lane;
    float v; if (sizeof(T) == 2) v = bf2f(*(const bf16_t*)p); else v = *(const float*)p;
    const float ss = wsum(v * v);
    const float o = v * rsqrtf(ss * (1.f / 64.f) + 1e-6f) * gain[lane];
    if (sizeof(T) == 2) *(bf16_t*)p = f2bf(o); else *(float*)p = o;
}

__global__ __launch_bounds__(64) void k_kmean(const bf16_t* __restrict__ Kb, int ld, float* __restrict__ kmean) {
    const int n = blockIdx.x % 64, h = blockIdx.x / 64, d = threadIdx.x;
    float s = 0.f;
    for (int j = 0; j < 256; ++j) s += bf2f(Kb[(size_t)(n * 256 + j) * ld + h * 64 + d]);
    kmean[((size_t)h * 64 + n) * 64 + d] = s * (1.f / 256.f);
}

template <typename KT> __device__ __forceinline__ void load_row64(const KT* p, float (&o)[64]);
template <> __device__ __forceinline__ void load_row64<float>(const float* p, float (&o)[64]) {
#pragma unroll
    for (int j = 0; j < 16; ++j) { const float4 v = ((const float4*)p)[j]; o[4 * j] = v.x; o[4 * j + 1] = v.y; o[4 * j + 2] = v.z; o[4 * j + 3] = v.w; }
}
template <> __device__ __forceinline__ void load_row64<bf16_t>(const bf16_t* p, float (&o)[64]) {
#pragma unroll
    for (int j = 0; j < 8; ++j) {
        const uint4 raw = ((const uint4*)p)[j];
        o[8 * j + 0] = __uint_as_float(raw.x << 16); o[8 * j + 1] = __uint_as_float(raw.x & 0xffff0000u);
        o[8 * j + 2] = __uint_as_float(raw.y << 16); o[8 * j + 3] = __uint_as_float(raw.y & 0xffff0000u);
        o[8 * j + 4] = __uint_as_float(raw.z << 16); o[8 * j + 5] = __uint_as_float(raw.z & 0xffff0000u);
        o[8 * j + 6] = __uint_as_float(raw.w << 16); o[8 * j + 7] = __uint_as_float(raw.w & 0xffff0000u);
    }
}
template <typename KT> __device__ __forceinline__ float ldf(const KT* p);
template <> __device__ __forceinline__ float ldf<float>(const float* p) { return *p; }
template <> __device__ __forceinline__ float ldf<bf16_t>(const bf16_t* p) { return bf2f(*p); }

template <bool MOBA, typename KT>
__global__ __launch_bounds__(256) void k_attn(bf16_t* proj, int ldq, int qcol0, int H, const float* __restrict__ qgain,
                                              const KT* __restrict__ Kf, const KT* __restrict__ Vf, int ldkv, const float* __restrict__ kmean) {
    __shared__ float sp[4][1024];
    const int wid = threadIdx.x >> 6, lane = threadIdx.x & 63;
    const int idx = blockIdx.x * 4 + wid;
    const int t = idx / H, h = idx % H;
    bf16_t* qp = proj + (size_t)t * ldq + qcol0 + h * 64;
    float qv[64];
    load_row64<bf16_t>(qp, qv);
    {
        float ss = 0.f;
#pragma unroll
        for (int d = 0; d < 64; ++d) ss += qv[d] * qv[d];
        const float r = rsqrtf(ss * (1.f / 64.f) + 1e-6f);
#pragma unroll
        for (int d = 0; d < 64; ++d) qv[d] = qv[d] * r * qgain[d];
    }
    constexpr int NB = MOBA ? 4 : 1;
    int blk[NB]; bool valid[NB];
    const int i_blk = t >> 8;
    float slope = 0.f;
    if (MOBA) {
        slope = exp2f(-8.0f * (float)(h + 1) / 12.0f);
        float gate = -INFINITY;
        {
            float kr[64];
            load_row64<float>(kmean + ((size_t)h * 64 + lane) * 64, kr);
            float g = 0.f;
#pragma unroll
            for (int d = 0; d < 64; ++d) g = fmaf(qv[d], kr[d], g);
            if (lane < i_blk) gate = g;
        }
#pragma unroll
        for (int r = 0; r < 3; ++r) {
            float v = gate; int i = lane;
#pragma unroll
            for (int o = 1; o < 64; o <<= 1) {
                const float ov = __shfl_xor(v, o); const int oi = __shfl_xor(i, o);
                if (ov > v || (ov == v && oi < i)) { v = ov; i = oi; }
            }
            blk[r] = i; valid[r] = v > -INFINITY;
            if (lane == i) gate = -INFINITY;
        }
        blk[3] = i_blk; valid[3] = true;
    } else { blk[0] = 0; valid[0] = true; }
    float s[NB][4];
    float mx = -INFINITY;
#pragma unroll
    for (int b = 0; b < NB; ++b) {
#pragma unroll
        for (int i = 0; i < 4; ++i) {
            const int j = lane + 64 * i;
            const int key = blk[b] * 256 + j;
            float kr[64];
            load_row64<KT>(Kf + (size_t)key * ldkv + h * 64, kr);
            float a = 0.f;
#pragma unroll
            for (int d = 0; d < 64; ++d) a = fmaf(qv[d], kr[d], a);
            a *= 0.125f;
            if (MOBA) {
                const int dist = t - key;
                a = a - slope * (float)dist;
                if (!valid[b] || dist < 0) a = -INFINITY;
            }
            s[b][i] = a; mx = fmaxf(mx, a);
        }
    }
    mx = wmax(mx);
    float l = 0.f;
#pragma unroll
    for (int b = 0; b < NB; ++b)
#pragma unroll
        for (int i = 0; i < 4; ++i) { const float p = __expf(s[b][i] - mx); l += p; sp[wid][b * 256 + lane + 64 * i] = p; }
    l = wsum(l);
    __syncthreads();
    float o = 0.f;
#pragma unroll
    for (int b = 0; b < NB; ++b) {
        const KT* vb = Vf + (size_t)(blk[b] * 256) * ldkv + h * 64 + lane;
        for (int j = 0; j < 256; ++j) o = fmaf(sp[wid][b * 256 + j], ldf<KT>(vb + (size_t)j * ldkv), o);
    }
    qp[lane] = f2bf(o / l);
}

__global__ __launch_bounds__(256) void k_rwkv_prep(const bf16_t* __restrict__ proj, const float* __restrict__ mu, const float* __restrict__ w0, const float* __restrict__ w2,
                                                   const float* __restrict__ a0, const float* __restrict__ a2, const float* __restrict__ k_k, const float* __restrict__ k_a,
                                                   const float* __restrict__ r_k, float* __restrict__ dec, float* __restrict__ aa, float* __restrict__ kkinv, float* __restrict__ sbon) {
    __shared__ float su[2560];
    __shared__ float st[64];
    __shared__ float skk[768];
    __shared__ float sbo[768];
    const int t = blockIdx.x, tid = threadIdx.x;
    for (int c = tid; c < 2560; c += 256) {
        const float cur = bf2f(proj[(size_t)t * 2816 + pcol_l1(c)]);
        const float prev = t > 0 ? bf2f(proj[(size_t)(t - 1) * 2816 + pcol_l1(c)]) : 0.f;
        su[c] = cur + (prev - cur) * mu[c];
    }
    __syncthreads();
    if (tid < 64) st[tid] = tanhf(su[2304 + tid]);
    __syncthreads();
    for (int c = tid; c < 768; c += 256) {
        float dw = w0[c], da = a0[c];
        for (int j = 0; j < 64; ++j) { dw = fmaf(st[j], w2[j * 768 + c], dw); da = fmaf(su[2368 + j], a2[j * 768 + c], da); }
        const float z = -dw;
        const float sp = fmaxf(z, 0.f) + log1pf(expf(-fabsf(z)));
        const float w_log = -sp - 0.5f;
        const float decay = expf(-expf(w_log));
        const float a = 1.f / (1.f + expf(-da));
        const float k = su[768 + c], r = su[c];
        const float kkv = k * k_k[c];
        const float kmod = k * (1.f + (a - 1.f) * k_a[c]);
        dec[(size_t)t * 768 + c] = decay; aa[(size_t)t * 768 + c] = a;
        skk[c] = kkv * kkv; sbo[c] = r * kmod * r_k[c];
    }
    __syncthreads();
    if (tid < 12) {
        float s1 = 0.f, s2 = 0.f;
        for (int j = 0; j < 64; ++j) { s1 += skk[tid * 64 + j]; s2 += sbo[tid * 64 + j]; }
        kkinv[(size_t)t * 12 + tid] = 1.f / fmaxf(sqrtf(s1), 1e-12f);
        sbon[(size_t)t * 12 + tid] = s2;
    }
}

__global__ __launch_bounds__(1024) void k_rwkv_scan(const bf16_t* __restrict__ proj, const float* __restrict__ mu, const float* __restrict__ k_k, const float* __restrict__ k_a,
                                                    const float* __restrict__ dec, const float* __restrict__ aa, const float* __restrict__ kkinv, float* __restrict__ ybuf, int M) {
    const int h = blockIdx.x, tid = threadIdx.x, v = tid >> 4, p = tid & 15;
    const int c0 = h * 64 + 4 * p;
    float st[4] = {0.f, 0.f, 0.f, 0.f};
    float mur[4], muk[4], kkg[4], kag[4];
#pragma unroll
    for (int j = 0; j < 4; ++j) { mur[j] = mu[c0 + j]; muk[j] = mu[768 + c0 + j]; kkg[j] = k_k[c0 + j]; kag[j] = k_a[c0 + j]; }
    const float muv = mu[1536 + h * 64 + v];
    float pr[4] = {0.f, 0.f, 0.f, 0.f}, pk[4] = {0.f, 0.f, 0.f, 0.f}, pv = 0.f;
    for (int t = 0; t < M; ++t) {
        const bf16_t* row = proj + (size_t)t * 2816;
        const uint2 rr = *(const uint2*)(row + 0 + c0);
        const uint2 kr = *(const uint2*)(row + 1024 + c0);
        const float cv = bf2f(row[1792 + h * 64 + v]);
        const float4 a4 = *(const float4*)(aa + (size_t)t * 768 + c0);
        const float4 d4 = *(const float4*)(dec + (size_t)t * 768 + c0);
        const float kinv = kkinv[(size_t)t * 12 + h];
        float cr[4], ck[4];
        cr[0] = __uint_as_float(rr.x << 16); cr[1] = __uint_as_float(rr.x & 0xffff0000u); cr[2] = __uint_as_float(rr.y << 16); cr[3] = __uint_as_float(rr.y & 0xffff0000u);
        ck[0] = __uint_as_float(kr.x << 16); ck[1] = __uint_as_float(kr.x & 0xffff0000u); ck[2] = __uint_as_float(kr.y << 16); ck[3] = __uint_as_float(kr.y & 0xffff0000u);
        const float a[4] = {a4.x, a4.y, a4.z, a4.w}, d[4] = {d4.x, d4.y, d4.z, d4.w};
        const float vs = cv + (pv - cv) * muv;
        float rs[4], kk[4], km[4], bb[4];
        float sa = 0.f;
#pragma unroll
        for (int j = 0; j < 4; ++j) {
            rs[j] = cr[j] + (pr[j] - cr[j]) * mur[j];
            const float ks = ck[j] + (pk[j] - ck[j]) * muk[j];
            kk[j] = ks * kkg[j] * kinv; km[j] = ks * (1.f + (a[j] - 1.f) * kag[j]); bb[j] = kk[j] * a[j];
            sa = fmaf(st[j], kk[j], sa);
            pr[j] = cr[j]; pk[j] = ck[j];
        }
        pv = cv;
        sa += __shfl_xor(sa, 1); sa += __shfl_xor(sa, 2); sa += __shfl_xor(sa, 4); sa += __shfl_xor(sa, 8);
        float y = 0.f;
#pragma unroll
        for (int j = 0; j < 4; ++j) { st[j] = st[j] * d[j] - sa * bb[j] + vs * km[j]; y = fmaf(st[j], rs[j], y); }
        y += __shfl_xor(y, 1); y += __shfl_xor(y, 2); y += __shfl_xor(y, 4); y += __shfl_xor(y, 8);
        if (p == 0) ybuf[(size_t)t * 768 + h * 64 + v] = y;
    }
}

__global__ __launch_bounds__(256) void k_rwkv_post(bf16_t* proj, const float* __restrict__ mu, const float* __restrict__ g2, const float* __restrict__ ln_w, const float* __restrict__ ln_b,
                                                   const float* __restrict__ ybuf, const float* __restrict__ sbon) {
    __shared__ float sg[128];
    __shared__ float sy[768];
    __shared__ float smean[12], srstd[12];
    const int t = blockIdx.x, tid = threadIdx.x;
    if (tid < 128) {
        const int c = 2432 + tid;
        const float cur = bf2f(proj[(size_t)t * 2816 + pcol_l1(c)]);
        const float prev = t > 0 ? bf2f(proj[(size_t)(t - 1) * 2816 + pcol_l1(c)]) : 0.f;
        const float u = cur + (prev - cur) * mu[c];
        sg[tid] = 1.f / (1.f + expf(-u));
    }
    for (int c = tid; c < 768; c += 256) sy[c] = ybuf[(size_t)t * 768 + c];
    __syncthreads();
    if (tid < 12) {
        float s = 0.f;
        for (int j = 0; j < 64; ++j) s += sy[tid * 64 + j];
        const float mean = s * (1.f / 64.f);
        float q = 0.f;
        for (int j = 0; j < 64; ++j) { const float dd = sy[tid * 64 + j] - mean; q += dd * dd; }
        smean[tid] = mean; srstd[tid] = rsqrtf(q * (1.f / 64.f) + 64e-5f);
    }
    __syncthreads();
    for (int c = tid; c < 768; c += 256) {
        const int h = c >> 6;
        float g = 0.f;
        for (int j = 0; j < 128; ++j) g = fmaf(sg[j], g2[j * 768 + c], g);
        const int vc = 1536 + c;
        const float cur = bf2f(proj[(size_t)t * 2816 + pcol_l1(vc)]);
        const float prev = t > 0 ? bf2f(proj[(size_t)(t - 1) * 2816 + pcol_l1(vc)]) : 0.f;
        const float vs = cur + (prev - cur) * mu[vc];
        const float y = (sy[c] - smean[h]) * srstd[h] * ln_w[c] + ln_b[c];
        proj[(size_t)t * 2816 + c] = f2bf((y + sbon[(size_t)t * 12 + h] * vs) * g);
    }
}

constexpr size_t MB = 1u << 20;
constexpr size_t O_RSTD = 0, O_KKINV = 1 * MB, O_SBON = 2 * MB, O_MEMKV = 3 * MB  , O_KMEAN = 4 * MB, O_MRSTD = 5 * MB;
constexpr size_t O_BIG = 8 * MB;
constexpr size_t O_ACT = O_BIG, O_PROJ = O_BIG, O_DEC = 101 * MB, O_AA = 152 * MB, O_YBUF = 203 * MB, O_KV = 200 * MB;

struct In {
    const float *x, *mem, *ffn1_norm, *ffn1_w1, *ffn1_w3, *ffn1_w2, *mix_norm, *w_out, *mem_norm, *w_mem_kv, *mem_q_norm, *mem_k_norm,
        *ffn2_norm, *ffn2_w1, *ffn2_w3, *ffn2_w2, *rwkv_w_in, *rwkv_mu, *rwkv_w0, *rwkv_w2, *rwkv_a0, *rwkv_a2, *rwkv_g2, *rwkv_k_k, *rwkv_k_a, *rwkv_r_k,
        *rwkv_ln_w, *rwkv_ln_b, *kv_norm, *w_kv, *kv_k_norm, *moba_w_in, *moba_q_norm;
};

static void ffn(const In& I, hipStream_t s, const float* xin, float* xout, const float* norm, const float* w1, const float* w3, const float* w2, unsigned char* ws) {
    float* rstd = (float*)(ws + O_RSTD); float* act = (float*)(ws + O_ACT);
    hipLaunchKernelGGL(k_rstd, dim3(16384 / 4), dim3(256), 0, s, xin, rstd, 16384);
    hipLaunchKernelGGL((k_gemm<2, false>), dim3(22, 16384 / 128), dim3(256), 0, s, (const void*)xin, 1024, rstd, norm, w1, w3, 2752, 1024, (void*)act, 2752, (const float*)nullptr, 0.f);
    hipLaunchKernelGGL((k_gemm<3, false>), dim3(1024 / 128, 16384 / 128), dim3(256), 0, s, (const void*)act, 2752, (const float*)nullptr, (const float*)nullptr, w2, (const float*)nullptr, 1024, 2752, (void*)xout, 1024, xin, 0.5f);
}
}
static void launch_naive(void* const* d_in, void* d_out, void* d_ws, hipStream_t s) {
    using namespace nv;
    In I;
    const float** ip = (const float**)&I;
    for (int i = 0; i < 33; ++i) ip[i] = (const float*)d_in[i];
    unsigned char* ws = (unsigned char*)d_ws;
    float* out = (float*)d_out;
    const int M = 16384;
    float* rstd = (float*)(ws + O_RSTD); float* mrstd = (float*)(ws + O_MRSTD);
    float* kkinv = (float*)(ws + O_KKINV); float* sbon = (float*)(ws + O_SBON);
    float* kmean = (float*)(ws + O_KMEAN);
    bf16_t* proj = (bf16_t*)(ws + O_PROJ);
    float* dec = (float*)(ws + O_DEC); float* aa = (float*)(ws + O_AA); float* ybuf = (float*)(ws + O_YBUF);
    bf16_t* KV = (bf16_t*)(ws + O_KV);
    const float* nul = nullptr;
    ffn(I, s, I.x, out, I.ffn1_norm, I.ffn1_w1, I.ffn1_w3, I.ffn1_w2, ws);
    hipLaunchKernelGGL(k_rstd, dim3(M / 4), dim3(256), 0, s, (const float*)out, rstd, M);
    hipLaunchKernelGGL((k_gemm<1, false>), dim3(22, M / 128), dim3(256), 0, s, (const void*)out, 1024, (const float*)rstd, I.mix_norm, I.rwkv_w_in, nul, 2816, 1024, (void*)proj, 2816, nul, 0.f);
    for (int l = 0; l < 2; ++l) {
        float* memkv = (float*)(ws + O_MEMKV + (size_t)l * 512 * 1024);
        hipLaunchKernelGGL(k_rstd, dim3(256 / 4), dim3(256), 0, s, I.mem, mrstd, 256);
        hipLaunchKernelGGL((k_gemm<0, false>), dim3(4, 2), dim3(256), 0, s, (const void*)I.mem, 1024, (const float*)mrstd, I.mem_norm + l * 1024, I.w_mem_kv + (size_t)l * 1024 * 512, nul, 512, 1024, (void*)memkv, 512, nul, 0.f);
        hipLaunchKernelGGL((k_headnorm<float>), dim3(256 * 4 / 4), dim3(256), 0, s, memkv, 512, 0, 4, I.mem_k_norm + l * 64, 256);
    }
    {
        const float* memkv = (const float*)(ws + O_MEMKV);
        hipLaunchKernelGGL((k_attn<false, float>), dim3(M * 4 / 4), dim3(256), 0, s, proj, 2816, 768, 4, I.mem_q_norm, memkv, memkv + 256, 512, nul);
    }
    hipLaunchKernelGGL(k_rwkv_prep, dim3(M), dim3(256), 0, s, (const bf16_t*)proj, I.rwkv_mu, I.rwkv_w0, I.rwkv_w2, I.rwkv_a0, I.rwkv_a2, I.rwkv_k_k, I.rwkv_k_a, I.rwkv_r_k, dec, aa, kkinv, sbon);
    hipLaunchKernelGGL(k_rwkv_scan, dim3(12), dim3(1024), 0, s, (const bf16_t*)proj, I.rwkv_mu, I.rwkv_k_k, I.rwkv_k_a, (const float*)dec, (const float*)aa, (const float*)kkinv, ybuf, M);
    hipLaunchKernelGGL(k_rwkv_post, dim3(M), dim3(256), 0, s, proj, I.rwkv_mu, I.rwkv_g2, I.rwkv_ln_w, I.rwkv_ln_b, (const float*)ybuf, (const float*)sbon);
    hipLaunchKernelGGL((k_gemm<3, true>), dim3(8, M / 128), dim3(256), 0, s, (const void*)proj, 2816, nul, nul, I.w_out, nul, 1024, 1024, (void*)out, 1024, (const float*)out, 1.0f);
    ffn(I, s, out, out, I.ffn2_norm, I.ffn2_w1, I.ffn2_w3, I.ffn2_w2, ws);
    hipLaunchKernelGGL(k_rstd, dim3(M / 4), dim3(256), 0, s, (const float*)out, rstd, M);
    hipLaunchKernelGGL((k_gemm<4, false>), dim3(12, M / 128), dim3(256), 0, s, (const void*)out, 1024, (const float*)rstd, I.kv_norm, I.w_kv, nul, 1536, 1024, (void*)KV, 1536, nul, 0.f);
    hipLaunchKernelGGL((k_headnorm<bf16_t>), dim3(M * 12 / 4), dim3(256), 0, s, KV, 1536, 0, 12, I.kv_k_norm, M);
    hipLaunchKernelGGL(k_kmean, dim3(64 * 12), dim3(64), 0, s, (const bf16_t*)KV, 1536, kmean);
    const size_t FW = (size_t)1024 * 2752;
    ffn(I, s, out, out, I.ffn1_norm + 1024, I.ffn1_w1 + FW, I.ffn1_w3 + FW, I.ffn1_w2 + FW, ws);
    hipLaunchKernelGGL(k_rstd, dim3(M / 4), dim3(256), 0, s, (const float*)out, rstd, M);
    hipLaunchKernelGGL((k_gemm<4, false>), dim3(8, M / 128), dim3(256), 0, s, (const void*)out, 1024, (const float*)rstd, I.mix_norm + 1024, I.moba_w_in, nul, 1024, 1024, (void*)proj, 1024, nul, 0.f);
    {
        const float* memkv = (const float*)(ws + O_MEMKV + 512 * 1024);
        hipLaunchKernelGGL((k_attn<false, float>), dim3(M * 4 / 4), dim3(256), 0, s, proj, 1024, 768, 4, I.mem_q_norm + 64, memkv, memkv + 256, 512, nul);
    }
    hipLaunchKernelGGL((k_attn<true, bf16_t>), dim3(M * 12 / 4), dim3(256), 0, s, proj, 1024, 0, 12, I.moba_q_norm, (const bf16_t*)KV, (const bf16_t*)KV + 768, 1536, (const float*)kmean);
    hipLaunchKernelGGL((k_gemm<3, true>), dim3(8, M / 128), dim3(256), 0, s, (const void*)proj, 1024, nul, nul, I.w_out + (size_t)1024 * 1024, nul, 1024, 1024, (void*)out, 1024, (const float*)out, 1.0f);
    ffn(I, s, out, out, I.ffn2_norm + 1024, I.ffn2_w1 + FW, I.ffn2_w3 + FW, I.ffn2_w2 + FW, ws);
}
extern "C" void kernel_launch(void* const* d_in, const int* in_sizes, int n_in, void* d_out, int out_size, void* d_ws, size_t ws_size, hipStream_t stream) {
    launch_naive(d_in, d_out, d_ws, stream);
}
```

```cpp
#include <hip/hip_runtime.h>
#include <cstdint>
#include <cstdio>
#include <cmath>

typedef unsigned short bf16_t;
__host__ __device__ __forceinline__ float bf2f(bf16_t b) { union { unsigned u; float f; } c; c.u = ((unsigned)b) << 16; return c.f; }
__host__ __device__ __forceinline__ bf16_t f2bf(float f) { union { unsigned u; float f; } c; c.f = f; const unsigned u = c.u; return (bf16_t)((u + 0x7fffu + ((u >> 16) & 1u)) >> 16); }
#define GAS __attribute__((address_space(1)))
#define LAS __attribute__((address_space(3)))
typedef unsigned v4u __attribute__((ext_vector_type(4)));
typedef float f32x4 __attribute__((ext_vector_type(4)));
typedef short bf16x8 __attribute__((ext_vector_type(8)));
typedef GAS unsigned gu32;
typedef GAS unsigned long long gu64;
#define RLX_AGENT __ATOMIC_RELAXED, __HIP_MEMORY_SCOPE_AGENT
#define LDS_WAIT() asm volatile("s_waitcnt lgkmcnt(0)" ::: "memory")
#define VM_WAIT() asm volatile("s_waitcnt vmcnt(0)" ::: "memory")
__device__ __forceinline__ unsigned long long rt() { return __builtin_amdgcn_s_memrealtime(); }

#define XB_TMO      128
#define XB_XCNT(j)  (256  + 64 * (j))
#define XB_XSUB(j)  (1280 + 64 * (j))
#define XB_XGEN(j)  (2304 + 64 * (j))
#define XB_TOP      3328
#define XB_TOPGEN   3392
#define XCD_BAR_WORDS 3456
#define XB_SPIN_CAP (1u << 18)

__device__ __forceinline__ unsigned xb_ld(unsigned* p)              { return __hip_atomic_load(p, __ATOMIC_RELAXED, __HIP_MEMORY_SCOPE_AGENT); }
__device__ __forceinline__ unsigned xb_add(unsigned* p, unsigned v) { return __hip_atomic_fetch_add(p, v, __ATOMIC_RELAXED, __HIP_MEMORY_SCOPE_AGENT); }
__device__ __forceinline__ unsigned xb_xcc_id() { return (unsigned)__builtin_amdgcn_s_getreg((3 << 11) | 20) & 0xFu; }
#define XB_SPIN(cond, bar) do { unsigned _sp = 0; while (cond) { __builtin_amdgcn_s_sleep(1); \
    if ((++_sp & 255u) == 0u) { if (xb_ld(&(bar)[XB_TMO])) break; if (_sp > XB_SPIN_CAP) { atomicAdd(&(bar)[XB_TMO], 1u); break; } } } } while (0)

struct XcdBarrier {
    unsigned* bar; unsigned x;
    volatile LAS unsigned* st;
};

__device__ __forceinline__ XcdBarrier xcd_barrier_post(unsigned* bar, volatile LAS unsigned* st) {
    XcdBarrier b; b.bar = bar; b.x = xb_xcc_id(); b.st = st;
    if (threadIdx.x == 0) (void)xb_add(&bar[XB_XCNT(b.x)], 1u);
    return b;
}
__device__ __forceinline__ void xcd_barrier_complete(unsigned* bar, unsigned x, unsigned& nloc, unsigned& nx) {
    const unsigned G = gridDim.x * gridDim.y * gridDim.z;
    unsigned sum, cnt, mine, sp = 0u;
    for (;;) {
        sum = 0u; cnt = 0u; mine = 0u;
#pragma unroll
        for (unsigned j = 0; j < 16; ++j) { const unsigned c = xb_ld(&bar[XB_XCNT(j)]); sum += c; cnt += (c > 0u) ? 1u : 0u; mine = (j == x) ? c : mine; }
        if (sum == G) break;
        __builtin_amdgcn_s_sleep(1);
        if ((++sp & 255u) == 0u) { if (xb_ld(&bar[XB_TMO])) break; if (sp > XB_SPIN_CAP) { atomicAdd(&bar[XB_TMO], 1u); break; } }
    }
    nloc = mine > 0u ? mine : 1u; nx = cnt > 0u ? cnt : 1u;
}

__device__ __forceinline__ void xcd_barrier(const XcdBarrier& b) {
    asm volatile("s_waitcnt vmcnt(0)" ::: "memory");
    __syncthreads();
    if (threadIdx.x == 0) {
        unsigned* bar = b.bar;
        __builtin_amdgcn_s_waitcnt(0);
        unsigned nloc = b.st[0], nx = b.st[1];
        if (nloc == 0u) { xcd_barrier_complete(bar, b.x, nloc, nx); b.st[0] = nloc; b.st[1] = nx; }
        const unsigned old = xb_add(&bar[XB_XSUB(b.x)], 1u);
        const unsigned gen = old / nloc;
        if (old + 1u == (gen + 1u) * nloc) {
            __builtin_amdgcn_fence(__ATOMIC_RELEASE, "agent");
            asm volatile("s_waitcnt vmcnt(0)" ::: "memory");
            const unsigned og = xb_add(&bar[XB_TOP], 1u);
            const unsigned tg = og / nx;
            if (og + 1u == (tg + 1u) * nx) xb_add(&bar[XB_TOPGEN], 1u);
            else XB_SPIN(xb_ld(&bar[XB_TOPGEN]) == tg, bar);
            __builtin_amdgcn_fence(__ATOMIC_ACQUIRE, "agent");
            xb_add(&bar[XB_XGEN(b.x)], 1u);
            asm volatile("s_waitcnt vmcnt(0)" ::: "memory");
        } else {
            XB_SPIN(xb_ld(&bar[XB_XGEN(b.x)]) == gen, bar);
            __builtin_amdgcn_fence(__ATOMIC_ACQUIRE, "agent");
            asm volatile("s_waitcnt vmcnt(0)" ::: "memory");
        }
    }
    __syncthreads();
}
namespace pg8 {
#define PG8_LAS __attribute__((address_space(3)))
typedef unsigned short bf16_t;
typedef short bf16x8 __attribute__((ext_vector_type(8)));
typedef float f32x4 __attribute__((ext_vector_type(4)));
typedef unsigned u32x4 __attribute__((ext_vector_type(4)));
constexpr int BM = 256, BK = 64, HALF = 128, HTB = HALF * BK * 2  , STAGE_BYTES = 8 * HTB, NXCD = 8, WGM = 8;

__host__ __device__ __forceinline__ int lds_byte(int r, int c) { const int st = (r >> 4) * 2 + (c >> 5), rr = r & 15, cc = c & 31, ob = rr * 64 + cc * 2; return st * 1024 + (ob ^ (((ob >> 9) & 1) << 5)); }
__host__ __device__ __forceinline__ void stage_rc(int b, int& R, int& C) { const int st = b / 1024, sb = b % 1024, swz = sb ^ (((sb >> 9) & 1) << 5); R = (st >> 1) * 16 + swz / 64; C = (st & 1) * 32 + (swz % 64) / 2; }
__host__ __device__ __forceinline__ int perm32(int rho) { const int n = rho >> 4, i = rho & 15; return 8 * (i >> 2) + 4 * n + (i & 3); }

struct Unit { int pm, pn; };
struct Gemm { const bf16_t* A; const bf16_t* Bt; int M, N, K, lda; };

struct StaticOrder {
    int nM, nN, nwg, G, c;
    __host__ __device__ void init(int M, int N, int G_, int c_) { nM = M / BM; nN = N / BM; nwg = nM * nN; G = G_; c = c_; }
    __host__ __device__ bool next(int i, Unit& u) const {
        const long L = (long)i * G + c; if (L >= nwg) return false;
        int wgid = (int)L; { const int q = nwg / NXCD, r = nwg % NXCD, xcd = wgid % NXCD, off = wgid / NXCD; wgid = (xcd < r ? xcd * (q + 1) : r * (q + 1) + (xcd - r) * q) + off; }
        const int nig = WGM * nN, gid = wgid / nig, fm = gid * WGM, gsz = (nM - fm) < WGM ? (nM - fm) : WGM;
        u.pm = fm + ((wgid % nig) % gsz); u.pn = (wgid % nig) / gsz; return true;
    }
    __device__ __forceinline__ void a_ready(const Unit&) const {}
    __device__ __forceinline__ void done(const Unit&) const {}
};

__device__ __forceinline__ unsigned cvt_pk_bf16(float lo, float hi) { unsigned r; asm volatile("v_cvt_pk_bf16_f32 %0, %1, %2" : "=v"(r) : "v"(lo), "v"(hi)); return r; }
__device__ __forceinline__ float row_rstd(const float* ssq, int row) {
    const f32x4* p = (const f32x4*)(ssq + (size_t)row * 16);
    const f32x4 a = p[0], b = p[1], c = p[2], d = p[3];
    const float s = ((a[0] + a[1]) + (a[2] + a[3])) + ((b[0] + b[1]) + (b[2] + b[3])) + ((c[0] + c[1]) + (c[2] + c[3])) + ((d[0] + d[1]) + (d[2] + d[3]));
    return rsqrtf(s * (1.0f / 1024.0f) + 1e-6f);
}
__device__ __forceinline__ float silu_mul(float a, float b) { return a * __builtin_amdgcn_rcpf(1.0f + __expf(-a)) * b; }

#define EPI_RSTD(row) (rt ? rt[(row) - rbase] : row_rstd(ssq, (row)))
struct EpiUpKV {
    static constexpr bool PERM = true, AFTER_DRAIN = false;
    bf16_t* act; const float* ssq; bf16_t* kv; int nkv; const PG8_LAS float* rt; int rbase;
    int nk; const float* kgain; float* kmean;
    __device__ __forceinline__ void operator()(const f32x4 (&acc)[2][2][4][2], const Unit& u, int wr, int wc, int fr, int fq) const {
        const int row0 = u.pm * BM + wr * 64 + fr;
        if (u.pn < nk) {
            const int h = 4 * u.pn + wc;
            float g[2][8], cm[2][8];
#pragma unroll
            for (int bj = 0; bj < 2; ++bj)
#pragma unroll
                for (int e = 0; e < 8; ++e) { g[bj][e] = kgain[32 * bj + 8 * fq + e]; cm[bj][e] = 0.f; }
#pragma unroll
            for (int ai = 0; ai < 2; ++ai)
#pragma unroll
                for (int m = 0; m < 4; ++m) { const int row = row0 + ai * HALF + m * 16; const float s = EPI_RSTD(row);
                    f32x4 v[2][2]; float q = 0.f;
#pragma unroll
                    for (int bj = 0; bj < 2; ++bj)
#pragma unroll
                        for (int n = 0; n < 2; ++n) { v[bj][n] = acc[ai][bj][m][n] * s; q += (v[bj][n][0] * v[bj][n][0] + v[bj][n][1] * v[bj][n][1]) + (v[bj][n][2] * v[bj][n][2] + v[bj][n][3] * v[bj][n][3]); }
                    q += __shfl_xor(q, 16); q += __shfl_xor(q, 32);
                    const float inv = rsqrtf(q * (1.f / 64.f) + 1e-6f);
                    bf16_t* rowp = kv + (size_t)row * 1536 + 64 * h + 8 * fq;
#pragma unroll
                    for (int bj = 0; bj < 2; ++bj) { float o[8];
#pragma unroll
                        for (int e = 0; e < 8; ++e) { o[e] = v[bj][e >> 2][e & 3] * inv * g[bj][e]; cm[bj][e] += o[e]; }
                        u32x4 w; w.x = cvt_pk_bf16(o[0], o[1]); w.y = cvt_pk_bf16(o[2], o[3]); w.z = cvt_pk_bf16(o[4], o[5]); w.w = cvt_pk_bf16(o[6], o[7]);
                        *(u32x4*)(rowp + 32 * bj) = w; } }
#pragma unroll
            for (int bj = 0; bj < 2; ++bj)
#pragma unroll
                for (int e = 0; e < 8; ++e) { float x = cm[bj][e]; x += __shfl_xor(x, 1); x += __shfl_xor(x, 2); x += __shfl_xor(x, 4); x += __shfl_xor(x, 8);
                    if (fr == 0) unsafeAtomicAdd(kmean + ((size_t)(h * 64 + u.pm)) * 64 + 32 * bj + 8 * fq + e, x * (1.f / 256.f)); }
        } else if (u.pn < nkv) {
            const int col0 = u.pn * BM + wc * 32 + 8 * fq;
#pragma unroll
            for (int ai = 0; ai < 2; ++ai)
#pragma unroll
                for (int m = 0; m < 4; ++m) { const int row = row0 + ai * HALF + m * 16; const float s = EPI_RSTD(row); bf16_t* rowp = kv + (size_t)row * 1536 + col0;
#pragma unroll
                    for (int bj = 0; bj < 2; ++bj) { const f32x4 v0 = acc[ai][bj][m][0] * s, v1 = acc[ai][bj][m][1] * s; u32x4 w;
                        w.x = cvt_pk_bf16(v0[0], v0[1]); w.y = cvt_pk_bf16(v0[2], v0[3]); w.z = cvt_pk_bf16(v1[0], v1[1]); w.w = cvt_pk_bf16(v1[2], v1[3]);
                        *(u32x4*)(rowp + bj * HALF) = w; } }
        } else {
            const int col0 = (u.pn - nkv) * HALF + wc * 32 + 8 * fq;
#pragma unroll
            for (int ai = 0; ai < 2; ++ai)
#pragma unroll
                for (int m = 0; m < 4; ++m) { const int row = row0 + ai * HALF + m * 16; const float s = EPI_RSTD(row);
                    const f32x4 a0 = acc[ai][0][m][0] * s, a1 = acc[ai][0][m][1] * s, b0 = acc[ai][1][m][0] * s, b1 = acc[ai][1][m][1] * s; u32x4 w;
                    w.x = cvt_pk_bf16(silu_mul(a0[0], b0[0]), silu_mul(a0[1], b0[1])); w.y = cvt_pk_bf16(silu_mul(a0[2], b0[2]), silu_mul(a0[3], b0[3]));
                    w.z = cvt_pk_bf16(silu_mul(a1[0], b1[0]), silu_mul(a1[1], b1[1])); w.w = cvt_pk_bf16(silu_mul(a1[2], b1[2]), silu_mul(a1[3], b1[3]));
                    *(u32x4*)(act + (size_t)row * 2816 + col0) = w; }
        }
    }
};
struct EpiProj {
    static constexpr bool PERM = true, AFTER_DRAIN = false;
    bf16_t* O; int ldc; const float* ssq; const PG8_LAS float* rt; int rbase;
    __device__ __forceinline__ void operator()(const f32x4 (&acc)[2][2][4][2], const Unit& u, int wr, int wc, int fr, int fq) const {
        const int row0 = u.pm * BM + wr * 64 + fr, col0 = u.pn * BM + wc * 32 + 8 * fq;
#pragma unroll
        for (int ai = 0; ai < 2; ++ai)
#pragma unroll
            for (int m = 0; m < 4; ++m) { const int row = row0 + ai * HALF + m * 16; const float s = EPI_RSTD(row); bf16_t* rowp = O + (size_t)row * ldc + col0;
#pragma unroll
                for (int bj = 0; bj < 2; ++bj) { const f32x4 v0 = acc[ai][bj][m][0] * s, v1 = acc[ai][bj][m][1] * s; u32x4 w;
                    w.x = cvt_pk_bf16(v0[0], v0[1]); w.y = cvt_pk_bf16(v0[2], v0[3]); w.z = cvt_pk_bf16(v1[0], v1[1]); w.w = cvt_pk_bf16(v1[2], v1[3]);
                    *(u32x4*)(rowp + bj * HALF) = w; } }
    }
};
struct EpiResid {
    static constexpr bool PERM = false, AFTER_DRAIN = false;
    bf16_t* xb; float* ssq_out; float* outf; float scale;
    __device__ __forceinline__ void operator()(const f32x4 (&acc)[2][2][4][2], const Unit& u, int wr, int wc, int fr, int fq) const {
        typedef unsigned u32x2v __attribute__((ext_vector_type(2)));
        const int col0 = u.pn * BM + wc * 32 + 4 * fq;
#pragma unroll
        for (int ai = 0; ai < 2; ++ai) {
            u32x2v pre[4][2][2];
#pragma unroll
            for (int m = 0; m < 4; ++m) { const size_t off = (size_t)(u.pm * BM + ai * HALF + wr * 64 + m * 16 + fr) * 1024 + col0;
#pragma unroll
                for (int bj = 0; bj < 2; ++bj)
#pragma unroll
                    for (int n = 0; n < 2; ++n) pre[m][bj][n] = *(const u32x2v*)(xb + off + bj * HALF + n * 16); }
#pragma unroll
            for (int m = 0; m < 4; ++m) { const int row = u.pm * BM + ai * HALF + wr * 64 + m * 16 + fr; const size_t off = (size_t)row * 1024 + col0; float q = 0.f;
#pragma unroll
                for (int bj = 0; bj < 2; ++bj)
#pragma unroll
                    for (int n = 0; n < 2; ++n) { const u32x2v p = pre[m][bj][n];
                        const f32x4 x = {__uint_as_float(p.x << 16), __uint_as_float(p.x & 0xffff0000u), __uint_as_float(p.y << 16), __uint_as_float(p.y & 0xffff0000u)};
                        const f32x4 o = x + acc[ai][bj][m][n] * scale;
                        if (outf) *(f32x4*)(outf + off + bj * HALF + n * 16) = o;
                        else { u32x2v w; w.x = cvt_pk_bf16(o[0], o[1]); w.y = cvt_pk_bf16(o[2], o[3]); *(u32x2v*)(xb + off + bj * HALF + n * 16) = w;
                               const f32x4 r = {__uint_as_float(w.x << 16), __uint_as_float(w.x & 0xffff0000u), __uint_as_float(w.y << 16), __uint_as_float(w.y & 0xffff0000u)};
                               q += (r[0] * r[0] + r[1] * r[1]) + (r[2] * r[2] + r[3] * r[3]); } }
                if (!outf) { q += __shfl_xor(q, 16); q += __shfl_xor(q, 32); if (fq == 0) ssq_out[(size_t)row * 16 + u.pn * 4 + wc] = q; } }
            asm volatile("" ::: "memory");
        }
    }
};
struct EpiMem {
    static constexpr bool PERM = true, AFTER_DRAIN = false;
    bf16_t* O; const float* rstd;
    __device__ __forceinline__ void operator()(const f32x4 (&acc)[2][2][4][2], const Unit& u, int wr, int wc, int fr, int fq) const {
        const int row0 = wr * 64 + fr, col0 = u.pn * BM + wc * 32 + 8 * fq;
#pragma unroll
        for (int ai = 0; ai < 2; ++ai)
#pragma unroll
            for (int m = 0; m < 4; ++m) { const int row = row0 + ai * HALF + m * 16; const float s = rstd[row]; bf16_t* rowp = O + (size_t)row * 1024 + col0;
#pragma unroll
                for (int bj = 0; bj < 2; ++bj) { const f32x4 v0 = acc[ai][bj][m][0] * s, v1 = acc[ai][bj][m][1] * s; u32x4 w;
                    w.x = cvt_pk_bf16(v0[0], v0[1]); w.y = cvt_pk_bf16(v0[2], v0[3]); w.z = cvt_pk_bf16(v1[0], v1[1]); w.w = cvt_pk_bf16(v1[2], v1[3]);
                    *(u32x4*)(rowp + bj * HALF) = w; } }
    }
};
struct OneUnitOrder {
    int pn;
    __device__ __forceinline__ bool next(int i, Unit& u) const { if (i > 0) return false; u.pm = 0; u.pn = pn; return true; }
    __device__ __forceinline__ void a_ready(const Unit&) const {}
    __device__ __forceinline__ void done(const Unit&) const {}
};
template <class Epi, class Sched, bool ALIGN_EPI = false, bool SP2 = false>
__device__ __forceinline__ void gemm_phase(PG8_LAS unsigned char* lds, const Gemm g, const Sched& S, const Epi& E) {
    const int tid = threadIdx.x, wid = __builtin_amdgcn_readfirstlane(tid >> 6), lane = tid & 63, wr = wid >> 2, wc = wid & 3, fr = lane & 15, fq = lane >> 4;
    const int K = g.K, nt = K / BK;
    unsigned voffA[2], voffB[2];
#pragma unroll
    for (int i = 0; i < 2; ++i) { int R, C; stage_rc(tid * 16 + i * 8192, R, C); const int Rb = Epi::PERM ? ((R & ~31) + perm32(R & 31)) : R;
        voffA[i] = (unsigned)(R * g.lda + C) * 2u; voffB[i] = (unsigned)(Rb * K + C) * 2u; }
    const size_t kstep = (size_t)(BK * 2);
    const size_t hstepB = (size_t)HALF * K * 2, hstepA = (size_t)HALF * g.lda * 2;
    const size_t tstepB = 2 * hstepB, tstepA = 2 * hstepA;
    const unsigned ldsw = (unsigned)wid * 1024u;
    const int aoff = lds_byte(wr * 64 + fr, fq * 8), boff = lds_byte(wc * 32 + fr, fq * 8);
#define PG8_SA(b, h) (((b) * 2 + (h)) * HTB)
#define PG8_SB(b, h) ((4 + (b) * 2 + (h)) * HTB)
#define PG8_STAGE(bufoff, gbase, voff) do { _Pragma("unroll") for (int _i = 0; _i < 2; ++_i) \
        __builtin_amdgcn_global_load_lds((const unsigned*)((const char*)(gbase) + (voff)[_i]), (PG8_LAS unsigned*)(lds + (bufoff) + ldsw + _i * 8192), 16, 0, 0); } while (0)
#define PG8_LDA(dst, b, h) do { _Pragma("unroll") for (int m = 0; m < 4; ++m) _Pragma("unroll") for (int k = 0; k < 2; ++k) dst[m][k] = *(const PG8_LAS bf16x8*)(lds + PG8_SA(b, h) + aoff + m * 2048 + k * 1024); } while (0)
#define PG8_LDB(dst, b, h) do { _Pragma("unroll") for (int n = 0; n < 2; ++n) _Pragma("unroll") for (int k = 0; k < 2; ++k) dst[n][k] = *(const PG8_LAS bf16x8*)(lds + PG8_SB(b, h) + boff + n * 2048 + k * 1024); } while (0)
#define PG8_MMA(ai, bj, At, Bt) do { __builtin_amdgcn_s_setprio(1); _Pragma("unroll") for (int m = 0; m < 4; ++m) _Pragma("unroll") for (int n = 0; n < 2; ++n) _Pragma("unroll") for (int k = 0; k < 2; ++k) \
        acc[ai][bj][m][n] = __builtin_amdgcn_mfma_f32_16x16x32_bf16(Bt[n][k], At[m][k], acc[ai][bj][m][n], 0, 0, 0); __builtin_amdgcn_s_setprio(0); } while (0)
#define PG8_WAIT_V(n) asm volatile("s_waitcnt vmcnt(" #n ")" ::: "memory")
#define PG8_WAIT_L(n) asm volatile("s_waitcnt lgkmcnt(" #n ")" ::: "memory")
#define PG8_BAR __builtin_amdgcn_s_barrier()
#define PG8_SCHED __builtin_amdgcn_sched_barrier(0)
    Unit cur, nxt; int ui = 0;
    if (!S.next(0, cur)) return;
    f32x4 acc[2][2][4][2];
#pragma unroll
    for (int a = 0; a < 2; ++a)
#pragma unroll
        for (int b = 0; b < 2; ++b)
#pragma unroll
            for (int m = 0; m < 4; ++m)
#pragma unroll
                for (int n = 0; n < 2; ++n) acc[a][b][m][n] = (f32x4){0.f, 0.f, 0.f, 0.f};
    bf16x8 At[4][2], B0[2][2], B1[2][2];
    const char* cA = (const char*)g.A + (size_t)cur.pm * tstepA; const char* cB = (const char*)g.Bt + (size_t)cur.pn * tstepB;
    S.a_ready(cur);
    if constexpr (SP2) {
        PG8_STAGE(PG8_SB(0, 0), cB, voffB); PG8_STAGE(PG8_SB(0, 1), cB + hstepB, voffB); PG8_STAGE(PG8_SA(0, 0), cA, voffA); PG8_STAGE(PG8_SA(0, 1), cA + hstepA, voffA);
        if (wr == 1) PG8_BAR;
        PG8_WAIT_V(2); PG8_BAR;
        PG8_STAGE(PG8_SB(1, 0), cB + kstep, voffB); PG8_STAGE(PG8_SA(1, 0), cA + kstep, voffA); PG8_STAGE(PG8_SB(1, 1), cB + hstepB + kstep, voffB);
        PG8_WAIT_V(6); PG8_BAR;
    } else {
        PG8_STAGE(PG8_SB(0, 0), cB, voffB); PG8_STAGE(PG8_SA(0, 0), cA, voffA); PG8_STAGE(PG8_SB(0, 1), cB + hstepB, voffB); PG8_STAGE(PG8_SA(0, 1), cA + hstepA, voffA);
        if (wr == 1) PG8_BAR;
        PG8_WAIT_V(4); PG8_BAR;
        PG8_STAGE(PG8_SB(1, 0), cB + kstep, voffB); PG8_STAGE(PG8_SA(1, 0), cA + kstep, voffA); PG8_STAGE(PG8_SB(1, 1), cB + hstepB + kstep, voffB);
        PG8_WAIT_V(6); PG8_BAR;
    }
    for (;;) {
        const bool has_next = S.next(ui + 1, nxt);
        const char* nA = has_next ? (const char*)g.A + (size_t)nxt.pm * tstepA : cA; const char* nB = has_next ? (const char*)g.Bt + (size_t)nxt.pn * tstepB : cB;
        for (int t = 0; t < nt; t += 2) {
            const bool last = (t == nt - 2);
            const char* a1 = cA + (size_t)(t + 1) * kstep;
            const char* a2 = last ? nA : cA + (size_t)(t + 2) * kstep; const char* b2 = last ? nB : cB + (size_t)(t + 2) * kstep;
            const char* a3 = a2 + kstep; const char* b3 = b2 + kstep;
            if (last && has_next) S.a_ready(nxt);
            if constexpr (SP2) {
            PG8_LDB(B0, 0, 0); PG8_LDB(B1, 0, 1); PG8_SCHED; PG8_LDA(At, 0, 0); PG8_STAGE(PG8_SA(1, 1), a1 + hstepA, voffA);
            PG8_WAIT_V(8); PG8_WAIT_L(0); PG8_BAR; PG8_MMA(0, 0, At, B0); PG8_MMA(0, 1, At, B1); PG8_BAR; PG8_SCHED;
            PG8_LDA(At, 0, 1); PG8_STAGE(PG8_SB(0, 0), b2, voffB); PG8_STAGE(PG8_SB(0, 1), b2 + hstepB, voffB); PG8_STAGE(PG8_SA(0, 0), a2, voffA);
            PG8_WAIT_V(8); PG8_WAIT_L(0); PG8_BAR; PG8_MMA(1, 0, At, B0); PG8_MMA(1, 1, At, B1); PG8_BAR; PG8_SCHED;
            PG8_LDB(B0, 1, 0); PG8_LDB(B1, 1, 1); PG8_SCHED; PG8_LDA(At, 1, 0); PG8_STAGE(PG8_SA(0, 1), a2 + hstepA, voffA);
            PG8_WAIT_V(8); PG8_WAIT_L(0); PG8_BAR; PG8_MMA(0, 0, At, B0); PG8_MMA(0, 1, At, B1); PG8_BAR; PG8_SCHED;
            PG8_LDA(At, 1, 1); PG8_STAGE(PG8_SB(1, 0), b3, voffB); PG8_STAGE(PG8_SB(1, 1), b3 + hstepB, voffB); PG8_STAGE(PG8_SA(1, 0), a3, voffA);
            PG8_WAIT_V(8); PG8_WAIT_L(0); PG8_BAR; PG8_MMA(1, 0, At, B0); PG8_MMA(1, 1, At, B1); PG8_BAR; PG8_SCHED;
            } else {
            PG8_LDB(B0, 0, 0); PG8_SCHED; PG8_LDA(At, 0, 0); PG8_STAGE(PG8_SA(1, 1), a1 + hstepA, voffA);
            PG8_WAIT_L(8); PG8_BAR; PG8_WAIT_L(0); PG8_MMA(0, 0, At, B0); PG8_BAR; PG8_SCHED;
            PG8_LDB(B1, 0, 1); PG8_STAGE(PG8_SB(0, 0), b2, voffB);
            PG8_BAR; PG8_WAIT_L(0); PG8_MMA(0, 1, At, B1); PG8_BAR;
            PG8_LDA(At, 0, 1); PG8_STAGE(PG8_SA(0, 0), a2, voffA);
            PG8_BAR; PG8_WAIT_L(0); PG8_MMA(1, 0, At, B0); PG8_BAR; PG8_SCHED;
            PG8_STAGE(PG8_SB(0, 1), b2 + hstepB, voffB);
            PG8_WAIT_V(6); PG8_BAR; PG8_MMA(1, 1, At, B1); PG8_BAR;
            PG8_LDB(B0, 1, 0); PG8_SCHED; PG8_LDA(At, 1, 0); PG8_STAGE(PG8_SA(0, 1), a2 + hstepA, voffA);
            PG8_WAIT_L(8); PG8_BAR; PG8_WAIT_L(0); PG8_MMA(0, 0, At, B0); PG8_BAR; PG8_SCHED;
            PG8_LDB(B1, 1, 1); PG8_STAGE(PG8_SB(1, 0), b3, voffB);
            PG8_BAR; PG8_WAIT_L(0); PG8_MMA(0, 1, At, B1); PG8_BAR;
            PG8_LDA(At, 1, 1); PG8_STAGE(PG8_SA(1, 0), a3, voffA);
            PG8_BAR; PG8_WAIT_L(0); PG8_MMA(1, 0, At, B0); PG8_BAR; PG8_SCHED;
            PG8_STAGE(PG8_SB(1, 1), b3 + hstepB, voffB);
            PG8_WAIT_V(6); PG8_BAR; PG8_MMA(1, 1, At, B1); PG8_BAR;
            }
        }
        if constexpr (ALIGN_EPI) { if (wr == 0) PG8_BAR; }
        if constexpr (!Epi::AFTER_DRAIN) { E(acc, cur, wr, wc, fr, fq); S.done(cur); }
        if (!has_next) break;
#pragma unroll
        for (int a = 0; a < 2; ++a)
#pragma unroll
            for (int b = 0; b < 2; ++b)
#pragma unroll
                for (int m = 0; m < 4; ++m)
#pragma unroll
                    for (int n = 0; n < 2; ++n) acc[a][b][m][n] = (f32x4){0.f, 0.f, 0.f, 0.f};
        cur = nxt; cA = nA; cB = nB; ++ui;
        if constexpr (ALIGN_EPI) { if (wr == 1) PG8_BAR; }
    }
    PG8_WAIT_V(0);
    if constexpr (!ALIGN_EPI) { if (wr == 0) PG8_BAR; }
    PG8_BAR;
    if constexpr (Epi::AFTER_DRAIN) { E.fused(acc, cur, wr, wc, fr, fq, lds, wid, lane); S.done(cur); }
#undef PG8_SA
#undef PG8_SB
#undef PG8_STAGE
#undef PG8_LDA
#undef PG8_LDB
#undef PG8_MMA
#undef PG8_WAIT_V
#undef PG8_WAIT_L
#undef PG8_BAR
#undef PG8_SCHED
}
}
namespace mk {
constexpr int NWAVES = 8;
constexpr int M = 16384, D = 1024, FF = 2752, FFP = 2816, AW = 2816, NH = 12, MIXW = 768, KVW = 1536;
constexpr size_t MiB = 1u << 20;
constexpr size_t WS_CTL = 0, CTL_ZERO_BYTES = 1 * MiB;
constexpr size_t WS_SSQ = 1 * MiB;
constexpr size_t WS_MEMKV = 2 * MiB;
constexpr size_t WS_KMEAN = 3 * MiB;
constexpr size_t WS_KKINV = 4 * MiB;
constexpr size_t WS_SBON = 5 * MiB;
constexpr size_t WS_SMALLW = 6 * MiB;
constexpr size_t WS_MEMB = 7 * MiB;
constexpr size_t SZ_FFN_UP = (size_t)5632 * 1024 * 2, SZ_FFN_DN = (size_t)1024 * 2816 * 2, SZ_FFN = SZ_FFN_UP + SZ_FFN_DN;
constexpr size_t WS_WKV = 8 * MiB;
constexpr size_t WS_WF1 = WS_WKV + (size_t)1536 * 1024 * 2;
constexpr size_t WS_WF2 = WS_WF1 + SZ_FFN;
constexpr size_t WS_WIN1 = WS_WF2 + SZ_FFN;
constexpr size_t WS_WOUT1 = WS_WIN1 + (size_t)2816 * 1024 * 2;
constexpr size_t WS_WOUT2 = WS_WOUT1 + (size_t)1024 * 1024 * 2;
constexpr size_t WS_WIN2 = WS_WOUT2 + (size_t)1024 * 1024 * 2;
constexpr size_t WS_WEND = WS_WIN2 + (size_t)1024 * 1024 * 2;
static_assert(WS_WEND <= 56 * MiB, "weights");
constexpr size_t WS_XB = 56 * MiB;
constexpr size_t WS_BIG = 88 * MiB;
constexpr size_t WS_KV = 176 * MiB;
constexpr size_t WS_E = 224 * MiB;
constexpr size_t WS_WMEM = WS_E + 28 * MiB;
constexpr size_t WS_END = 256 * MiB;
constexpr int CW_BAR = 4096;
constexpr int CW_CNT = 8192;
constexpr int CW_TS = 10240;

constexpr int RING_OFF = 0, RING_BYTES = 131072;
constexpr int LDSCTL_OFF = RING_BYTES, MISC_OFF = LDSCTL_OFF + 320;
constexpr int RTAB_OFF = LDSCTL_OFF + 1024;
constexpr int LDS_BYTES = 147456;
static_assert(RTAB_OFF + 8192 <= LDS_BYTES, "LDS map");

struct Args { const float* in[33]; float* out; unsigned char* ws; int ph_lo, ph_hi, bar_region, pad; };

struct Frame {
    LAS unsigned char* lds;
    int tid, lane, wave, vcu, G;
};

__device__ __forceinline__ float wave_sum(float v) {
#pragma unroll
    for (int o = 1; o < 64; o <<= 1) v += __shfl_xor(v, o);
    return v;
}
typedef float f32x2_t __attribute__((ext_vector_type(2))); typedef __bf16 bf16x2_t __attribute__((ext_vector_type(2)));
__device__ __forceinline__ unsigned cvtpk(float lo, float hi) { f32x2_t v = {lo, hi}; bf16x2_t b = __builtin_convertvector(v, bf16x2_t); return __builtin_bit_cast(unsigned, b); }
__device__ __forceinline__ unsigned pk2(float lo, float hi) { return cvtpk(lo, hi); }
__device__ __forceinline__ bf16_t f2bf_d(float f) { return (bf16_t)(cvtpk(f, f) & 0xffffu); }

__device__ __forceinline__ void conv_item(const float* __restrict__ W, int N, const float* __restrict__ gain, bf16_t* dst, int ldd, int rowbase, LAS float* scr, int k0, int n0, int lane, bool split = false) {
    const int r4 = lane >> 4, c4 = (lane & 15) * 4;
    f32x4 v[8];
#pragma unroll
    for (int i = 0; i < 8; ++i) v[i] = *(const f32x4*)(W + (size_t)(k0 + 4 * i + r4) * N + n0 + c4);
#pragma unroll
    for (int i = 0; i < 8; ++i) { const int kk = 4 * i + r4; const float g = gain ? gain[k0 + kk] : 1.f; LAS float* s = scr + kk * 65 + c4; s[0] = g * v[i][0]; s[1] = g * v[i][1]; s[2] = g * v[i][2]; s[3] = g * v[i][3]; }
    asm volatile("s_waitcnt lgkmcnt(0)" ::: "memory");
    const int c = lane & 3;
#pragma unroll
    for (int j = 0; j < 4; ++j) { const int n = (lane >> 2) + 16 * j; const LAS float* s = scr + (8 * c) * 65 + n;
        v4u o; o.x = pk2(s[0 * 65], s[1 * 65]); o.y = pk2(s[2 * 65], s[3 * 65]); o.z = pk2(s[4 * 65], s[5 * 65]); o.w = pk2(s[6 * 65], s[7 * 65]);
        *(v4u*)(dst + (size_t)(rowbase + n + ((split && (n & 32)) ? 96 : 0)) * ldd + k0 + 8 * c) = o; }
    asm volatile("s_waitcnt lgkmcnt(0)" ::: "memory");
}
__device__ __forceinline__ int rmap(int kind, int n) {
    if (kind == 1) return 256 * (n >> 7) + (n & 127);
    if (kind == 2) return 256 * (n >> 7) + 128 + (n & 127);
    if (kind == 3) return n < 768 ? n : (n < 2560 ? n + 256 : n - 2560 + 768);
    if (kind == 4 && n < 768) return 256 * (n >> 8) + 32 * ((n >> 6) & 3);
    return n;
}
__device__ __forceinline__ void conv_matrix(const Frame& F, const float* W, int K, int N, const float* gain, bf16_t* dst, int ldd, int kind) {
    LAS float* scr = (LAS float*)(F.lds + RING_OFF + F.wave * 16384);
    const int gw = F.vcu * NWAVES + F.wave, NGW = F.G * NWAVES;
    const int nblk = N / 64, items = (K / 32) * nblk;
    for (int it = gw; it < items; it += NGW) { const int kb = it / nblk, nb = it % nblk; conv_item(W, N, gain, dst, ldd, rmap(kind, 64 * nb), scr, 32 * kb, 64 * nb, F.lane, kind == 4 && 64 * nb < 768); }
}
__device__ __forceinline__ void conv_ffn(const Frame& F, const float* norm, const float* w1, const float* w3, const float* w2, unsigned char* slot, unsigned char* dn_at = nullptr) {
    bf16_t* up = (bf16_t*)slot; bf16_t* dn = (bf16_t*)(dn_at ? dn_at : slot + SZ_FFN_UP);
    conv_matrix(F, w1, 1024, FF, norm, up, 1024, 1);
    conv_matrix(F, w3, 1024, FF, norm, up, 1024, 2);
    conv_matrix(F, w2, FF, 1024, nullptr, dn, FFP, 0);
    const int gt = (F.vcu * NWAVES + F.wave) * 64 + F.lane, NT = F.G * NWAVES * 64;
    for (int i = gt; i < 16384; i += NT) { const int r = i >> 7, c = i & 127; const int row = 21 * 256 + (r < 64 ? 64 + r : 192 + (r - 64)); *(v4u*)(up + (size_t)row * 1024 + c * 8) = (v4u){0u, 0u, 0u, 0u}; }
    for (int i = gt; i < 8192; i += NT) { const int r = i >> 3, c = i & 7; *(v4u*)(dn + (size_t)r * FFP + FF + c * 8) = (v4u){0u, 0u, 0u, 0u}; }
}
__device__ __forceinline__ void x_to_xb(const Frame& F, const float* x, bf16_t* xb, float* ssq, int rows, bool rstd_mode) {
    const int gw = F.vcu * NWAVES + F.wave, NGW = F.G * NWAVES;
    for (int m = 2 * gw; m < rows; m += 2 * NGW) {
        const f32x4* xr = (const f32x4*)(x + (size_t)m * D) + F.lane; float s0 = 0.f, s1 = 0.f;
        unsigned long long* o8 = (unsigned long long*)(xb + (size_t)m * D) + F.lane;
        f32x4 v[8];
#pragma unroll
        for (int j = 0; j < 4; ++j) { v[j] = xr[64 * j]; v[4 + j] = xr[256 + 64 * j]; }
#pragma unroll
        for (int j = 0; j < 4; ++j) {
            s0 += (v[j][0] * v[j][0] + v[j][1] * v[j][1]) + (v[j][2] * v[j][2] + v[j][3] * v[j][3]);
            s1 += (v[4 + j][0] * v[4 + j][0] + v[4 + j][1] * v[4 + j][1]) + (v[4 + j][2] * v[4 + j][2] + v[4 + j][3] * v[4 + j][3]);
            o8[64 * j] = (unsigned long long)pk2(v[j][0], v[j][1]) | ((unsigned long long)pk2(v[j][2], v[j][3]) << 32);
            o8[256 + 64 * j] = (unsigned long long)pk2(v[4 + j][0], v[4 + j][1]) | ((unsigned long long)pk2(v[4 + j][2], v[4 + j][3]) << 32); }
        s0 = wave_sum(s0); s1 = wave_sum(s1);
        if (rstd_mode) { if (F.lane == 0) { ssq[m] = rsqrtf(s0 * (1.f / 1024.f) + 1e-6f); ssq[m + 1] = rsqrtf(s1 * (1.f / 1024.f) + 1e-6f); } }
        else if (F.lane < 32) ssq[(size_t)m * 16 + F.lane] = F.lane == 0 ? s0 : (F.lane == 16 ? s1 : 0.f);
    }
}
__device__ __forceinline__ void k_post(const Frame& F, bf16_t* KV, const float* kgain, float* kmean) {
    LAS float* sred = (LAS float*)(F.lds + RING_OFF);
    for (int u = blockIdx.x; u < 256; u += F.G) {
        const int b = u >> 2, hg = u & 3;
        float accm[3] = {0.f, 0.f, 0.f};
        const float g = kgain[F.lane];
        for (int r0 = F.wave * 8; r0 < 256; r0 += NWAVES * 8) {
            bf16_t* rowp = KV + (size_t)(b * 256 + r0) * 1536 + hg * 192 + F.lane;
            float v[8][3], ss[8][3];
#pragma unroll
            for (int j = 0; j < 8; ++j)
#pragma unroll
                for (int h = 0; h < 3; ++h) { v[j][h] = bf2f(rowp[(size_t)j * 1536 + h * 64]); ss[j][h] = v[j][h] * v[j][h]; }
#pragma unroll
            for (int o = 1; o < 64; o <<= 1)
#pragma unroll
                for (int j = 0; j < 8; ++j)
#pragma unroll
                    for (int h = 0; h < 3; ++h) ss[j][h] += __shfl_xor(ss[j][h], o);
#pragma unroll
            for (int j = 0; j < 8; ++j)
#pragma unroll
                for (int h = 0; h < 3; ++h) { const float o = v[j][h] * rsqrtf(ss[j][h] * (1.f / 64.f) + 1e-6f) * g; rowp[(size_t)j * 1536 + h * 64] = f2bf_d(o); accm[h] += o; }
        }
#pragma unroll
        for (int h = 0; h < 3; ++h) sred[(F.wave * 3 + h) * 64 + F.lane] = accm[h];
        __syncthreads();
        if (F.tid < 192) { float s = 0.f;
#pragma unroll
            for (int w = 0; w < 8; ++w) s += sred[w * 192 + F.tid];
            kmean[((size_t)(hg * 3 + (F.tid >> 6)) * 64 + b) * 64 + (F.tid & 63)] = s * (1.f / 256.f); }
        __syncthreads();
    }
}
constexpr int RW_MP = 144, RW_MSZ = 64 * RW_MP;
constexpr int L_TW = 0, L_AD = RW_MSZ, L_VT = 2 * RW_MSZ, L_KA = 3 * RW_MSZ, L_BT = 4 * RW_MSZ, L_KT = 5 * RW_MSZ, L_RT = 6 * RW_MSZ, L_BH = 7 * RW_MSZ, L_KH = 8 * RW_MSZ,
              L_AAB = 9 * RW_MSZ, L_AAK = 10 * RW_MSZ, L_G3 = 11 * RW_MSZ, L_G4 = 12 * RW_MSZ, L_DP = 13 * RW_MSZ, L_G63 = L_DP + 3072, L_CS = L_G63 + 256, L_NP = L_CS + 512, L_BP = L_NP + 1024, L_RW_END = L_BP + 1024;
static_assert(L_RW_END <= RING_BYTES, "rwkv LDS");
typedef unsigned u32x2 __attribute__((ext_vector_type(2)));
__device__ __forceinline__ u32x2 pack4(f32x4 v) { u32x2 r; r.x = cvtpk(v[0], v[1]); r.y = cvtpk(v[2], v[3]); return r; }
__device__ __forceinline__ f32x4 unpack4(u32x2 r) { f32x4 v; v[0] = __uint_as_float(r.x << 16); v[1] = __uint_as_float(r.x & 0xffff0000u); v[2] = __uint_as_float(r.y << 16); v[3] = __uint_as_float(r.y & 0xffff0000u); return v; }
__device__ __forceinline__ bf16x8 frag2(u32x2 lo, u32x2 hi) { v4u t; t.x = lo.x; t.y = lo.y; t.z = hi.x; t.w = hi.y; return __builtin_bit_cast(bf16x8, t); }
__device__ __forceinline__ bf16x8 lds16(const LAS unsigned char* p) { return *(const LAS bf16x8*)p; }
__device__ __forceinline__ u32x2 lds8(const LAS unsigned char* p) { return *(const LAS u32x2*)p; }
__device__ __forceinline__ float ldsbf(const LAS unsigned char* p) { return bf2f(*(const LAS bf16_t*)p); }
__device__ __forceinline__ void unpack8(v4u raw, float (&f)[8]) {
    f[0] = __uint_as_float(raw.x << 16); f[1] = __uint_as_float(raw.x & 0xffff0000u); f[2] = __uint_as_float(raw.y << 16); f[3] = __uint_as_float(raw.y & 0xffff0000u);
    f[4] = __uint_as_float(raw.z << 16); f[5] = __uint_as_float(raw.z & 0xffff0000u); f[6] = __uint_as_float(raw.w << 16); f[7] = __uint_as_float(raw.w & 0xffff0000u);
}
#define MFMA16(a, b, c) __builtin_amdgcn_mfma_f32_16x16x32_bf16((a), (b), (c), 0, 0, 0)
__device__ __forceinline__ float dpp_ror(float v, int) { return v; }
#define DPP_ROR_ADD(v, n) ((v) + __int_as_float(__builtin_amdgcn_update_dpp(0, __float_as_int(v), 0x120 + (n), 0xf, 0xf, false)))
__device__ __forceinline__ float grp16_sum(float v) { v = DPP_ROR_ADD(v, 8); v = DPP_ROR_ADD(v, 4); v = DPP_ROR_ADD(v, 2); v = DPP_ROR_ADD(v, 1); return v; }

struct RwkvW { const float *mu, *w0, *a0, *k_k, *k_a, *r_k, *ln_w, *ln_b; const bf16_t *W2T, *A2T, *G2T; };
struct RwkvBuf { unsigned char *MC, *NC, *PF, *Y0; float* SB; };

constexpr int L_RS = L_AAB, L_KS = L_AAB + 17408;
__device__ __forceinline__ float fast_sigmoid(float x) { return __builtin_amdgcn_rcpf(1.f + __expf(-x)); }
__device__ __forceinline__ float fast_tanh(float x) { return 1.f - 2.f * __builtin_amdgcn_rcpf(1.f + __expf(2.f * x)); }
struct S1Head { v4u cr, pr, ck, pk, cv, pv; bf16x8 bw0, bw1, ba0, ba1; float w0c, a0c, kkc, kac, rkc; };
__device__ __forceinline__ void s1_load_raw(S1Head& H, const bf16_t* proj, int t0, int h, int tid) {
    const int i = tid >> 3, j0 = (tid & 7) * 8, t = t0 + i;
    const bf16_t* rowc = proj + (size_t)t * 2816 + h * 64 + j0;
    H.cr = *(const v4u*)(rowc); H.ck = *(const v4u*)(rowc + 1024); H.cv = *(const v4u*)(rowc + 1792);
    H.pr = (v4u){0u, 0u, 0u, 0u}; H.pk = H.pr; H.pv = H.pr;
    if (t > 0) { H.pr = *(const v4u*)(rowc - 2816); H.pk = *(const v4u*)(rowc - 2816 + 1024); H.pv = *(const v4u*)(rowc - 2816 + 1792); }
}
__device__ __forceinline__ void s1_load_frags(S1Head& H, const RwkvW& W, int h, int kt, int lo, int hi) {
    const int ch = h * 64 + 16 * kt + lo;
    H.bw0 = *(const bf16x8*)(W.W2T + (size_t)ch * 64 + 8 * hi); H.bw1 = *(const bf16x8*)(W.W2T + (size_t)ch * 64 + 8 * hi + 32);
    H.ba0 = *(const bf16x8*)(W.A2T + (size_t)ch * 64 + 8 * hi); H.ba1 = *(const bf16x8*)(W.A2T + (size_t)ch * 64 + 8 * hi + 32);
    H.w0c = W.w0[ch]; H.a0c = W.a0[ch]; H.rkc = W.r_k[ch];
}
__device__ __forceinline__ void s1_load_k(S1Head& H, const RwkvW& W, int h, int kt, int lo) { const int ch = h * 64 + 16 * kt + lo; H.kkc = W.k_k[ch]; H.kac = W.k_a[ch]; }
__device__ __forceinline__ void s1_write_head(const S1Head& H, LAS unsigned char* lds, const RwkvW& W, int h, int tid) {
    const int i = tid >> 3, j0 = (tid & 7) * 8, ch0 = h * 64 + j0;
    float cf[8], pf[8];
    unpack8(H.cr, cf); unpack8(H.pr, pf);
    { const f32x4 m0 = *(const f32x4*)(W.mu + ch0), m1 = *(const f32x4*)(W.mu + ch0 + 4);
      f32x4 o0 = {cf[0] + (pf[0] - cf[0]) * m0[0], cf[1] + (pf[1] - cf[1]) * m0[1], cf[2] + (pf[2] - cf[2]) * m0[2], cf[3] + (pf[3] - cf[3]) * m0[3]};
      f32x4 o1 = {cf[4] + (pf[4] - cf[4]) * m1[0], cf[5] + (pf[5] - cf[5]) * m1[1], cf[6] + (pf[6] - cf[6]) * m1[2], cf[7] + (pf[7] - cf[7]) * m1[3]};
      *(LAS f32x4*)(lds + L_RS + (i * 68 + j0) * 4) = o0; *(LAS f32x4*)(lds + L_RS + (i * 68 + j0 + 4) * 4) = o1; }
    unpack8(H.ck, cf); unpack8(H.pk, pf);
    { const f32x4 m0 = *(const f32x4*)(W.mu + 768 + ch0), m1 = *(const f32x4*)(W.mu + 768 + ch0 + 4);
      f32x4 o0 = {cf[0] + (pf[0] - cf[0]) * m0[0], cf[1] + (pf[1] - cf[1]) * m0[1], cf[2] + (pf[2] - cf[2]) * m0[2], cf[3] + (pf[3] - cf[3]) * m0[3]};
      f32x4 o1 = {cf[4] + (pf[4] - cf[4]) * m1[0], cf[5] + (pf[5] - cf[5]) * m1[1], cf[6] + (pf[6] - cf[6]) * m1[2], cf[7] + (pf[7] - cf[7]) * m1[3]};
      *(LAS f32x4*)(lds + L_KS + (i * 68 + j0) * 4) = o0; *(LAS f32x4*)(lds + L_KS + (i * 68 + j0 + 4) * 4) = o1; }
    unpack8(H.cv, cf); unpack8(H.pv, pf);
#pragma unroll
    for (int e = 0; e < 8; ++e) { const float vs = cf[e] + (pf[e] - cf[e]) * W.mu[1536 + ch0 + e]; *(LAS bf16_t*)(lds + L_VT + (j0 + e) * RW_MP + i * 2) = f2bf_d(vs); }
}
__device__ __forceinline__ void rwkv_s1(const Frame& F, const bf16_t* proj, const RwkvW& W, const RwkvBuf& B) {
    LAS unsigned char* lds = F.lds + RING_OFF;
    const int tid = F.tid, lane = F.lane, w = F.wave, lo = lane & 15, hi = lane >> 4;
    const u32x2 z2 = {0u, 0u};
    const int kt = w & 3, ih = w >> 2, k = 16 * kt + lo;
    for (int c = blockIdx.x; c < 256; c += F.G) {
        const int t0 = c * 64;
        {
            const int i = tid >> 3, j0 = (tid & 7) * 8, t = t0 + i;
            const bf16_t* rowc = proj + (size_t)t * 2816; const bool hasp = t > 0;
            v4u cw = *(const v4u*)(rowc + 2560 + j0), ca = *(const v4u*)(rowc + 2624 + j0);
            v4u pw = {0u, 0u, 0u, 0u}, pa = pw;
            if (hasp) { pw = *(const v4u*)(rowc - 2816 + 2560 + j0); pa = *(const v4u*)(rowc - 2816 + 2624 + j0); }
            float cf[8], pf[8], o[8];
            unpack8(cw, cf); unpack8(pw, pf);
#pragma unroll
            for (int e = 0; e < 8; ++e) o[e] = fast_tanh(cf[e] + (pf[e] - cf[e]) * W.mu[2304 + j0 + e]);
            { v4u r; r.x = cvtpk(o[0], o[1]); r.y = cvtpk(o[2], o[3]); r.z = cvtpk(o[4], o[5]); r.w = cvtpk(o[6], o[7]); *(LAS v4u*)(lds + L_TW + i * RW_MP + j0 * 2) = r; }
            unpack8(ca, cf); unpack8(pa, pf);
#pragma unroll
            for (int e = 0; e < 8; ++e) o[e] = cf[e] + (pf[e] - cf[e]) * W.mu[2368 + j0 + e];
            { v4u r; r.x = cvtpk(o[0], o[1]); r.y = cvtpk(o[2], o[3]); r.z = cvtpk(o[4], o[5]); r.w = cvtpk(o[6], o[7]); *(LAS v4u*)(lds + L_AD + i * RW_MP + j0 * 2) = r; }
        }
        S1Head Hc;
        s1_load_raw(Hc, proj, t0, 0, tid); s1_load_frags(Hc, W, 0, kt, lo, hi); s1_load_k(Hc, W, 0, kt, lo);
        s1_write_head(Hc, lds, W, 0, tid);
        __syncthreads();
        for (int h = 0; h < 12; ++h) {
            const int item = c * 12 + h;
            const int hn = h + 1 < 12 ? h + 1 : 11;
            float lw[2][4], av[2][4], kr[2][4], rr[2][4], L[2][4];
#pragma unroll
            for (int itl = 0; itl < 2; ++itl) {
                const int it = 2 * ih + itl;
                const LAS unsigned char* ap = lds + (16 * it + lo) * RW_MP + 16 * hi;
                f32x4 dw = {0.f, 0.f, 0.f, 0.f}, da = dw;
                dw = MFMA16(lds16(ap + L_TW), Hc.bw0, dw); dw = MFMA16(lds16(ap + L_TW + 64), Hc.bw1, dw);
                da = MFMA16(lds16(ap + L_AD), Hc.ba0, da); da = MFMA16(lds16(ap + L_AD + 64), Hc.ba1, da);
#pragma unroll
                for (int r = 0; r < 4; ++r) {
                    const int i = 16 * it + 4 * hi + r;
                    rr[itl][r] = *(const LAS float*)(lds + L_RS + (i * 68 + k) * 4); kr[itl][r] = *(const LAS float*)(lds + L_KS + (i * 68 + k) * 4);
                    const float zz = -(Hc.w0c + dw[r]);
                    const float sp = fmaxf(zz, 0.f) + __logf(1.f + __expf(-fabsf(zz)));
                    lw[itl][r] = -__expf(-sp - 0.5f);
                    av[itl][r] = fast_sigmoid(Hc.a0c + da[r]);
                }
            }
            {
                float ttile0 = 0.f;
#pragma unroll
                for (int itl = 0; itl < 2; ++itl) {
                    float p0 = lw[itl][0], p1 = p0 + lw[itl][1], p2 = p1 + lw[itl][2], p3 = p2 + lw[itl][3];
                    const float s0 = __shfl(p3, lo), s1 = __shfl(p3, lo + 16), s2 = __shfl(p3, lo + 32), s3 = __shfl(p3, lo + 48);
                    const float ex = (hi > 0 ? s0 : 0.f) + (hi > 1 ? s1 : 0.f) + (hi > 2 ? s2 : 0.f) + (itl ? ttile0 : 0.f);
                    L[itl][0] = ex + p0; L[itl][1] = ex + p1; L[itl][2] = ex + p2; L[itl][3] = ex + p3;
                    if (itl == 0) ttile0 = (s0 + s1) + (s2 + s3); else if (hi == 0) *(LAS float*)(lds + L_CS + (ih * 64 + k) * 4) = ttile0 + ((s0 + s1) + (s2 + s3));
#pragma unroll
                    for (int r = 0; r < 4; ++r) {
                        const float kkv = kr[itl][r] * Hc.kkc, kmod = kr[itl][r] * (1.f + (av[itl][r] - 1.f) * Hc.kac);
                        const float q = grp16_sum(kkv * kkv), bq = grp16_sum(rr[itl][r] * kmod * Hc.rkc);
                        if (lo == 0) { const int i = 16 * (2 * ih + itl) + 4 * hi + r; *(LAS float*)(lds + L_NP + (i * 4 + kt) * 4) = q; *(LAS float*)(lds + L_BP + (i * 4 + kt) * 4) = bq; }
                    }
                }
            }
            s1_load_frags(Hc, W, hn, kt, lo, hi);
            __syncthreads();
            {
                const float cs0 = *(const LAS float*)(lds + L_CS + k * 4), cs1 = *(const LAS float*)(lds + L_CS + (64 + k) * 4);
                const float base = ih ? cs0 : 0.f, L63 = cs0 + cs1;
                const float g63v = __expf(L63);
                if (ih == 0 && hi == 0) *(LAS float*)(lds + L_G63 + k * 4) = g63v;
                if (tid < 64) { const f32x4 bp = *(const LAS f32x4*)(lds + L_BP + tid * 16); B.SB[(size_t)(t0 + tid) * 12 + h] = (bp[0] + bp[1]) + (bp[2] + bp[3]); }
#pragma unroll
                for (int itl = 0; itl < 2; ++itl) {
                    const int it = 2 * ih + itl;
                    f32x4 bh, kh;
#pragma unroll
                    for (int r = 0; r < 4; ++r) {
                        const int i = 16 * it + 4 * hi + r;
                        const f32x4 np = *(const LAS f32x4*)(lds + L_NP + i * 16);
                        const float ninv = __builtin_amdgcn_rcpf(fmaxf(__builtin_amdgcn_sqrtf((np[0] + np[1]) + (np[2] + np[3])), 1e-12f));
                        const float Li = L[itl][r] + base, Lp = Li - lw[itl][r];
                        const float a = av[itl][r], kraw = kr[itl][r];
                        const float kap = kraw * Hc.kkc * ninv, b = kap * a, kmod = kraw * (1.f + (a - 1.f) * Hc.kac);
                        const float eL = __expf(Li), emL = __builtin_amdgcn_rcpf(eL), eLp = __expf(Lp), eE = g63v * emL;
                        const int off = i * RW_MP + k * 2;
                        *(LAS bf16_t*)(lds + L_KA + off) = f2bf_d(kap * eLp);
                        *(LAS bf16_t*)(lds + L_BT + off) = f2bf_d(b * emL);
                        *(LAS bf16_t*)(lds + L_KT + off) = f2bf_d(kmod * emL);
                        *(LAS bf16_t*)(lds + L_RT + off) = f2bf_d(rr[itl][r] * eL);
                        bh[r] = b * eE; kh[r] = kmod * eE;
                    }
                    *(LAS u32x2*)(lds + L_BH + k * RW_MP + (16 * it + 4 * hi) * 2) = pack4(bh);
                    *(LAS u32x2*)(lds + L_KH + k * RW_MP + (16 * it + 4 * hi) * 2) = pack4(kh);
                }
            }
            s1_load_raw(Hc, proj, t0, hn, tid); s1_load_k(Hc, W, hn, kt, lo);
            __syncthreads();
            {
                const int mat = w >> 1, hf = w & 1;
                const int offA = (mat & 1) ? L_KT : L_BT, offB = (mat & 2) ? L_RT : L_KA, dst = L_AAB + mat * RW_MSZ;
    #pragma unroll
                for (int e = 0; e < 2; ++e) {
                    const int it = hf ? (1 + e) : (3 * e);
                    const LAS unsigned char* bp = lds + offB + (16 * it + lo) * RW_MP + 16 * hi;
                    const bf16x8 b0 = lds16(bp), b1 = lds16(bp + 64);
                    for (int st = 0; st < 4; ++st) {
                        f32x4 acc = {0.f, 0.f, 0.f, 0.f};
                        if (st <= it) {
                            const LAS unsigned char* ap = lds + offA + (16 * st + lo) * RW_MP + 16 * hi;
                            acc = MFMA16(lds16(ap), b0, acc); acc = MFMA16(lds16(ap + 64), b1, acc);
                            const int i = 16 * it + lo, s0 = 16 * st + 4 * hi;
    #pragma unroll
                            for (int r = 0; r < 4; ++r) { const bool keep = (mat < 2) ? (s0 + r < i) : (s0 + r <= i); acc[r] = keep ? acc[r] : 0.f; }
                        }
                        *(LAS u32x2*)(lds + dst + (16 * it + lo) * RW_MP + (16 * st + 4 * hi) * 2) = pack4(acc);
                    }
                }
            }
            __syncthreads();
            f32x4 xacc[4];
    #pragma unroll
            for (int p = 0; p < 4; ++p) xacc[p] = (f32x4){0.f, 0.f, 0.f, 0.f};
            if (w == 0) {
                float Dc[16];
                int lo_o = lo; asm volatile("" : "+v"(lo_o));
    #pragma unroll
                for (int m = 0; m < 16; ++m) {
                    float acc = (m == lo_o) ? 1.f : 0.f;
    #pragma unroll
                    for (int s = 0; s < m; ++s) acc -= ldsbf(lds + L_AAB + (16 * hi + m) * RW_MP + (16 * hi + s) * 2) * Dc[s];
                    Dc[m] = acc;
                    *(LAS bf16_t*)(lds + L_DP + (16 * hi + m) * 48 + lo * 2) = f2bf_d(acc);
                }
            } else if (w >= 4) {
                const int vt = w - 4;
                const LAS unsigned char* bp = lds + L_VT + (16 * vt + lo) * RW_MP + 16 * hi;
                const bf16x8 b0 = lds16(bp), b1 = lds16(bp + 64);
    #pragma unroll
                for (int it = 0; it < 4; ++it) { const LAS unsigned char* ap = lds + L_AAK + (16 * it + lo) * RW_MP + 16 * hi; xacc[it] = MFMA16(lds16(ap), b0, xacc[it]); xacc[it] = MFMA16(lds16(ap + 64), b1, xacc[it]); }
            }
            __syncthreads();
            const int ct = w & 3; const bool isU = w >= 4;
            u32x2 xp[4];
    #pragma unroll
            for (int p = 0; p < 4; ++p) {
                f32x4 Z;
                if (!isU) {
    #pragma unroll
                    for (int r = 0; r < 4; ++r) Z[r] = ldsbf(lds + L_KA + (16 * p + 4 * hi + r) * RW_MP + (16 * ct + lo) * 2);
                } else Z = -xacc[p];
                if (p >= 1) {
                    f32x4 S = {0.f, 0.f, 0.f, 0.f};
                    const LAS unsigned char* ar = lds + L_AAB + (16 * p + lo) * RW_MP + (4 * hi) * 2;
                    S = MFMA16(frag2(lds8(ar), p >= 2 ? lds8(ar + 32) : z2), frag2(xp[0], p >= 2 ? xp[1] : z2), S);
                    if (p == 3) S = MFMA16(frag2(lds8(ar + 64), z2), frag2(xp[2], z2), S);
                    Z = Z - S;
                }
                const f32x4 X = MFMA16(frag2(lds8(lds + L_DP + (16 * p + lo) * 48 + (4 * hi) * 2), z2), frag2(pack4(Z), z2), ((f32x4){0.f, 0.f, 0.f, 0.f}));
                xp[p] = pack4(X);
            }
            unsigned char* gM = B.MC + (size_t)item * 8192; unsigned char* gN = B.NC + (size_t)item * 8192; unsigned char* gP = B.PF + (size_t)item * 8192; unsigned char* gY = B.Y0 + (size_t)item * 8192;
            const bf16x8 x01 = frag2(xp[0], xp[1]), x23 = frag2(xp[2], xp[3]);
            if (!isU) {
                const int kt2 = ct;
    #pragma unroll
                for (int mt = 0; mt < 4; ++mt) {
                    const LAS unsigned char* bp = lds + L_BH + (16 * mt + lo) * RW_MP + (4 * hi) * 2;
                    f32x4 acc = {0.f, 0.f, 0.f, 0.f};
                    acc = MFMA16(x01, frag2(lds8(bp), lds8(bp + 32)), acc); acc = MFMA16(x23, frag2(lds8(bp + 64), lds8(bp + 96)), acc);
                    const float g63 = *(const LAS float*)(lds + L_G63 + (16 * mt + lo) * 4);
                    f32x4 mv;
    #pragma unroll
                    for (int r = 0; r < 4; ++r) mv[r] = ((16 * kt2 + 4 * hi + r) == (16 * mt + lo) ? g63 : 0.f) - acc[r];
                    *(u32x2*)(gM + (mt * 2 + (kt2 >> 1)) * 1024 + lane * 16 + (kt2 & 1) * 8) = pack4(mv);
                }
    #pragma unroll
                for (int it = 0; it < 4; ++it) {
                    const LAS unsigned char* bp = lds + L_G3 + (16 * it + lo) * RW_MP + (4 * hi) * 2;
                    f32x4 acc = {0.f, 0.f, 0.f, 0.f};
                    acc = MFMA16(x01, frag2(lds8(bp), lds8(bp + 32)), acc); acc = MFMA16(x23, frag2(lds8(bp + 64), lds8(bp + 96)), acc);
                    const f32x4 rt = unpack4(lds8(lds + L_RT + (16 * it + lo) * RW_MP + (16 * kt2 + 4 * hi) * 2));
                    *(u32x2*)(gP + (it * 2 + (kt2 >> 1)) * 1024 + lane * 16 + (kt2 & 1) * 8) = pack4(rt - acc);
                }
            } else {
                const int vt = ct;
                const LAS unsigned char* vp = lds + L_VT + (16 * vt + lo) * RW_MP + 16 * hi;
                const bf16x8 v0 = lds16(vp), v1 = lds16(vp + 64);
    #pragma unroll
                for (int mt = 0; mt < 4; ++mt) {
                    const LAS unsigned char* ap = lds + L_BH + (16 * mt + lo) * RW_MP + (4 * hi) * 2;
                    const LAS unsigned char* kp = lds + L_KH + (16 * mt + lo) * RW_MP + 16 * hi;
                    f32x4 acc = {0.f, 0.f, 0.f, 0.f};
                    acc = MFMA16(frag2(lds8(ap), lds8(ap + 32)), x01, acc); acc = MFMA16(frag2(lds8(ap + 64), lds8(ap + 96)), x23, acc);
                    acc = MFMA16(lds16(kp), v0, acc); acc = MFMA16(lds16(kp + 64), v1, acc);
                    *(u32x2*)(gN + (vt * 4 + mt) * 512 + lane * 8) = pack4(acc);
                }
    #pragma unroll
                for (int it = 0; it < 4; ++it) {
                    const LAS unsigned char* ap = lds + L_G3 + (16 * it + lo) * RW_MP + (4 * hi) * 2;
                    const LAS unsigned char* kp = lds + L_G4 + (16 * it + lo) * RW_MP + 16 * hi;
                    f32x4 acc = {0.f, 0.f, 0.f, 0.f};
                    acc = MFMA16(x01, frag2(lds8(ap), lds8(ap + 32)), acc); acc = MFMA16(x23, frag2(lds8(ap + 64), lds8(ap + 96)), acc);
                    acc = MFMA16(v0, lds16(kp), acc); acc = MFMA16(v1, lds16(kp + 64), acc);
                    *(u32x2*)(gY + (vt * 4 + it) * 512 + lane * 8) = pack4(acc);
                }
            }

            __syncthreads();
            if (h + 1 < 12) s1_write_head(Hc, lds, W, h + 1, tid);
            __syncthreads();
        }
    }
}

constexpr int S2_SLOT = 10240;
#define S2_WAITV(n) asm volatile("s_waitcnt vmcnt(" #n ")" ::: "memory")
#define S2L_LOAD(R, cc) do { const unsigned char* g_ = lbase + (size_t)((cc) < 256 ? (cc) : 255) * cstride; R[0] = *(const v4u*)(g_); R[1] = *(const v4u*)(g_ + 1024); } while (0)
#define S2L_STEP(R, k) do { S2_WAITV(46); \
    LAS unsigned char* sl_ = lds + ((k) & 7) * S2_SLOT + (2 * lw) * 1024 + lane * 16; \
    *(LAS v4u*)(sl_) = R[0]; *(LAS v4u*)(sl_ + 1024) = R[1]; \
    S2L_LOAD(R, (k) + 24); } while (0)
#define S2L_GROUP(Ra_, Rb_, Rc_, Rd_, k) do { S2L_STEP(Ra_, k); S2L_STEP(Rb_, (k) + 1); S2L_STEP(Rc_, (k) + 2); S2L_STEP(Rd_, (k) + 3); \
    asm volatile("s_waitcnt lgkmcnt(0)" ::: "memory"); __builtin_amdgcn_s_barrier(); } while (0)
#define S2M_READ(Mr, Nr, sl) do { const LAS unsigned char* sp_ = lds + (sl) * S2_SLOT + lane * 16; \
    _Pragma("unroll") for (int f = 0; f < 8; ++f) Mr[f] = *(const LAS bf16x8*)(sp_ + f * 1024); \
    const LAS unsigned char* np_ = lds + (sl) * S2_SLOT + 8192 + lane * 8; \
    _Pragma("unroll") for (int mt = 0; mt < 4; ++mt) Nr[mt] = *(const LAS u32x2*)(np_ + mt * 512); } while (0)
#define S2_STEP(Mc, Nc, Mn, Nn, cc, BAR) do { if (BAR) { asm volatile("s_waitcnt lgkmcnt(0)" ::: "memory"); __builtin_amdgcn_s_barrier(); } \
    S2M_READ(Mn, Nn, ((cc) + 1) & 7); \
    f32x4 acc[4]; \
    _Pragma("unroll") for (int mt = 0; mt < 4; ++mt) { acc[mt] = unpack4(Nc[mt]); acc[mt] = MFMA16(Mc[mt * 2], Hf0, acc[mt]); acc[mt] = MFMA16(Mc[mt * 2 + 1], Hf1, acc[mt]); } \
    unsigned char* hp = nb + (size_t)(cc) * cstride + lane * 16; \
    *(bf16x8*)(hp) = Hf0; *(bf16x8*)(hp + 1024) = Hf1;     \
    Hf0 = frag2(pack4(acc[0]), pack4(acc[1])); Hf1 = frag2(pack4(acc[2]), pack4(acc[3])); } while (0)
constexpr int S2_NWG = 64;
__device__ __forceinline__ void rwkv_s2(const Frame& F, const RwkvBuf& B) {
    const int g = blockIdx.x;
    if (g >= S2_NWG) return;
    int h, vs;
    if (g < 32) { h = g & 7; vs = g >> 3; } else { if ((g & 7) >= 4) return; h = 8 + (g & 7); vs = (g - 32) >> 3; }
    LAS unsigned char* lds = F.lds + RING_OFF;
    const int lane = F.lane, w = F.wave;
    const unsigned char* mb = B.MC + (size_t)h * 8192;
    unsigned char* nb = B.NC + (size_t)h * 8192 + vs * 2048;
    const size_t cstride = (size_t)12 * 8192;
    if (w >= 1 && w < 6) {
        const int lw = w - 1;
        const unsigned char* lbase = (lw < 4 ? mb + (2 * lw) * 1024 : (const unsigned char*)nb) + lane * 16;
        v4u R0[2], R1[2], R2[2], R3[2], R4[2], R5[2], R6[2], R7[2], R8[2], R9[2], Ra[2], Rb[2];
        v4u Rc[2], Rd[2], Re[2], Rf[2], Rg[2], Rh[2], Ri[2], Rj[2], Rk[2], Rl[2], Rm[2], Rn[2];
        S2L_LOAD(R0, 0); S2L_LOAD(R1, 1); S2L_LOAD(R2, 2); S2L_LOAD(R3, 3); S2L_LOAD(R4, 4); S2L_LOAD(R5, 5);
        S2L_LOAD(R6, 6); S2L_LOAD(R7, 7); S2L_LOAD(R8, 8); S2L_LOAD(R9, 9); S2L_LOAD(Ra, 10); S2L_LOAD(Rb, 11);
        S2L_LOAD(Rc, 12); S2L_LOAD(Rd, 13); S2L_LOAD(Re, 14); S2L_LOAD(Rf, 15); S2L_LOAD(Rg, 16); S2L_LOAD(Rh, 17);
        S2L_LOAD(Ri, 18); S2L_LOAD(Rj, 19); S2L_LOAD(Rk, 20); S2L_LOAD(Rl, 21); S2L_LOAD(Rm, 22); S2L_LOAD(Rn, 23);
#pragma unroll 1
        for (int k = 0; k < 264; k += 24) {
            S2L_GROUP(R0, R1, R2, R3, k);      S2L_GROUP(R4, R5, R6, R7, k + 4);   S2L_GROUP(R8, R9, Ra, Rb, k + 8);
            S2L_GROUP(Rc, Rd, Re, Rf, k + 12); S2L_GROUP(Rg, Rh, Ri, Rj, k + 16);  S2L_GROUP(Rk, Rl, Rm, Rn, k + 20);
        }
    } else if (w >= 6) {
#pragma unroll 1
        for (int j = 0; j < 66; ++j) __builtin_amdgcn_s_barrier();
    } else {
        bf16x8 Hf0 = {0, 0, 0, 0, 0, 0, 0, 0}, Hf1 = Hf0;
        bf16x8 Ma[8], Mb[8];
        u32x2 Na[4], Nb[4];
        __builtin_amdgcn_s_barrier();
        S2M_READ(Ma, Na, 0);
#pragma unroll 1
        for (int c = 0; c < 256; c += 4) {
            S2_STEP(Ma, Na, Mb, Nb, c, false);
            S2_STEP(Mb, Nb, Ma, Na, c + 1, false);
            S2_STEP(Ma, Na, Mb, Nb, c + 2, false);
            S2_STEP(Mb, Nb, Ma, Na, c + 3, true);
        }
        __builtin_amdgcn_s_barrier();
    }
}

constexpr int L3_SG = 0, L3_SGP = 272;
__device__ __forceinline__ void rwkv_s3(const Frame& F, bf16_t* proj, const RwkvW& W, const RwkvBuf& B) {
    LAS unsigned char* lds = F.lds + RING_OFF;
    const int tid = F.tid, lane = F.lane, w = F.wave, lo = lane & 15, hi = lane >> 4;
    const int it = w & 3, par = w >> 2;
    for (int c = blockIdx.x; c < 256; c += F.G) {
        const int t0 = c * 64;
        {
            const int i = tid >> 3, j0 = (tid & 7) * 16, t = t0 + i;
            const bf16_t* rowc = proj + (size_t)t * 2816 + 2688 + j0;
#pragma unroll
            for (int hh = 0; hh < 2; ++hh) {
                const v4u cg = *(const v4u*)(rowc + 8 * hh); v4u pg = {0u, 0u, 0u, 0u};
                if (t > 0) pg = *(const v4u*)(rowc - 2816 + 8 * hh);
                float cf[8], pf[8], o[8]; unpack8(cg, cf); unpack8(pg, pf);
#pragma unroll
                for (int e = 0; e < 8; ++e) o[e] = fast_sigmoid(cf[e] + (pf[e] - cf[e]) * W.mu[2432 + j0 + 8 * hh + e]);
                v4u r; r.x = cvtpk(o[0], o[1]); r.y = cvtpk(o[2], o[3]); r.z = cvtpk(o[4], o[5]); r.w = cvtpk(o[6], o[7]);
                *(LAS v4u*)(lds + L3_SG + i * L3_SGP + (j0 + 8 * hh) * 2) = r;
            }
        }
        __syncthreads();
        const LAS unsigned char* sp = lds + L3_SG + (16 * it + lo) * L3_SGP + 16 * hi;
        const bf16x8 sg0 = lds16(sp), sg1 = lds16(sp + 64), sg2 = lds16(sp + 128), sg3 = lds16(sp + 192);
        const int t = t0 + 16 * it + lo;
        bf16_t* rowc = proj + (size_t)t * 2816;
#pragma unroll 2
        for (int hh = 0; hh < 6; ++hh) {
            const int h = 2 * hh + par, item = c * 12 + h, ch0 = h * 64 + 4 * hi;
            const unsigned char* gN = B.NC + (size_t)item * 8192; const unsigned char* gP = B.PF + (size_t)item * 8192; const unsigned char* gY = B.Y0 + (size_t)item * 8192;
            const bf16x8 P0 = *(const bf16x8*)(gP + (it * 2 + 0) * 1024 + lane * 16), P1 = *(const bf16x8*)(gP + (it * 2 + 1) * 1024 + lane * 16);
            const float sb = B.SB[(size_t)t * 12 + h];
            f32x4 y[4], g[4]; u32x2 cv[4], pv[4], Yi[4]; bf16x8 Hq[8], Gq[16];
#pragma unroll
            for (int vt = 0; vt < 4; ++vt) {
                Hq[2 * vt] = *(const bf16x8*)(gN + (vt * 2 + 0) * 1024 + lane * 16); Hq[2 * vt + 1] = *(const bf16x8*)(gN + (vt * 2 + 1) * 1024 + lane * 16);
                Yi[vt] = *(const u32x2*)(gY + (vt * 4 + it) * 512 + lane * 8);
                const bf16_t* gp = W.G2T + (size_t)(h * 64 + 16 * vt + lo) * 128 + 8 * hi;
                Gq[4 * vt] = *(const bf16x8*)(gp); Gq[4 * vt + 1] = *(const bf16x8*)(gp + 32); Gq[4 * vt + 2] = *(const bf16x8*)(gp + 64); Gq[4 * vt + 3] = *(const bf16x8*)(gp + 96);
                cv[vt] = *(const u32x2*)(rowc + 1792 + ch0 + 16 * vt); pv[vt] = (u32x2){0u, 0u};
                if (t > 0) pv[vt] = *(const u32x2*)(rowc - 2816 + 1792 + ch0 + 16 * vt);
            }
#pragma unroll
            for (int vt = 0; vt < 4; ++vt) {
                y[vt] = unpack4(Yi[vt]);
                y[vt] = MFMA16(Hq[2 * vt], P0, y[vt]); y[vt] = MFMA16(Hq[2 * vt + 1], P1, y[vt]);
                g[vt] = (f32x4){0.f, 0.f, 0.f, 0.f};
                g[vt] = MFMA16(Gq[4 * vt], sg0, g[vt]); g[vt] = MFMA16(Gq[4 * vt + 1], sg1, g[vt]); g[vt] = MFMA16(Gq[4 * vt + 2], sg2, g[vt]); g[vt] = MFMA16(Gq[4 * vt + 3], sg3, g[vt]);
            }
            float s = 0.f;
#pragma unroll
            for (int vt = 0; vt < 4; ++vt) s += (y[vt][0] + y[vt][1]) + (y[vt][2] + y[vt][3]);
            s += __shfl_xor(s, 16); s += __shfl_xor(s, 32);
            const float mean = s * (1.f / 64.f);
            float m2 = 0.f;
#pragma unroll
            for (int vt = 0; vt < 4; ++vt) { const f32x4 d = y[vt] - mean; m2 += (d[0] * d[0] + d[1] * d[1]) + (d[2] * d[2] + d[3] * d[3]); }
            m2 += __shfl_xor(m2, 16); m2 += __shfl_xor(m2, 32);
            const float rstd = rsqrtf(m2 * (1.f / 64.f) + 64e-5f);
#pragma unroll
            for (int vt = 0; vt < 4; ++vt) {
                const int ch = ch0 + 16 * vt;
                const f32x4 lnw = *(const f32x4*)(W.ln_w + ch), lnb = *(const f32x4*)(W.ln_b + ch), muv = *(const f32x4*)(W.mu + 1536 + ch);
                const f32x4 cvf = unpack4(cv[vt]), pvf = unpack4(pv[vt]);
                const f32x4 vs = cvf + (pvf - cvf) * muv;
                const f32x4 yn = (y[vt] - mean) * rstd * lnw + lnb;
                *(u32x2*)(rowc + ch) = pack4((yn + vs * sb) * g[vt]);
            }
        }
        __syncthreads();
    }
}
constexpr int AT_KP = 144, AT_VP = 528;
constexpr int L_AK = 0, L_AV = 256 * AT_KP, L_AEND = L_AV + 256 * AT_KP, L_APFX = L_AEND;
static_assert(L_APFX + 8192 <= RING_BYTES, "attn LDS");
constexpr float QSCALE = 0.125f * 1.4426950408889634f;

typedef short v4i16_t __attribute__((ext_vector_type(4)));
__device__ __forceinline__ u32x2 ldstr8(const LAS unsigned char* p) { return __builtin_bit_cast(u32x2, __builtin_amdgcn_ds_read_tr16_b64_v4i16((LAS v4i16_t*)p)); }
template <bool BIAS, bool CAUSAL>
__device__ __forceinline__ void attn_core(const LAS unsigned char* lds, bf16x8 q0, bf16x8 q1, int npairs, float slope2, float trel, int lo, int hi, f32x4 (&o)[4], float& l) {
#pragma unroll 1
    for (int kp = 0; kp < npairs; ++kp) {
        f32x4 s[2];
#pragma unroll
        for (int e = 0; e < 2; ++e) {
            const int kt = 2 * kp + e;
            const LAS unsigned char* ap = lds + L_AK + (16 * kt + lo) * AT_KP + 16 * hi;
            f32x4 a = {0.f, 0.f, 0.f, 0.f};
            a = MFMA16(lds16(ap), q0, a); a = MFMA16(lds16(ap + 64), q1, a);
            const float kb = (float)(16 * kt + 4 * hi);
#pragma unroll
            for (int r = 0; r < 4; ++r) {
                float x = a[r];
                if (BIAS) { x = x + (slope2 * (kb + (float)r) - slope2 * trel); if (CAUSAL && kb + (float)r > trel) x = -INFINITY; }
                const float p = __builtin_amdgcn_exp2f(x); l += p; a[r] = p;
            }
            s[e] = a;
        }
        const bf16x8 pf = frag2(pack4(s[0]), pack4(s[1]));
#pragma unroll
        for (int dt = 0; dt < 4; ++dt) {
            const LAS unsigned char* vp = lds + L_AV + (32 * kp + 4 * hi + (lo >> 2)) * AT_KP + (16 * dt + 4 * (lo & 3)) * 2;
            o[dt] = MFMA16(frag2(ldstr8(vp), ldstr8(vp + 16 * AT_KP)), pf, o[dt]);
        }
    }
}
struct KvRegs { v4u k[4], v[4]; };
__device__ __forceinline__ void kv_load(KvRegs& R, const bf16_t* Ksrc, const bf16_t* Vsrc, int ld, int tid) {
    const int row = tid >> 1, hf = tid & 1;
    const v4u* kp = (const v4u*)(Ksrc + (size_t)row * ld + hf * 32); const v4u* vp = (const v4u*)(Vsrc + (size_t)row * ld + hf * 32);
#pragma unroll
    for (int j = 0; j < 4; ++j) { R.k[j] = kp[j]; R.v[j] = vp[j]; }
}
__device__ __forceinline__ void kv_write(const KvRegs& R, LAS unsigned char* lds, int tid) {
    const int row = tid >> 1, hf = tid & 1;
#pragma unroll
    for (int j = 0; j < 4; ++j) {
        *(LAS v4u*)(lds + L_AK + row * AT_KP + hf * 64 + j * 16) = R.k[j];
        *(LAS v4u*)(lds + L_AV + row * AT_KP + hf * 64 + j * 16) = R.v[j];
    }
}
__device__ __forceinline__ void stage_kv_bf16(LAS unsigned char* lds, const bf16_t* Ksrc, const bf16_t* Vsrc, int ld, int tid) { KvRegs R; kv_load(R, Ksrc, Vsrc, ld, tid); kv_write(R, lds, tid); }
__device__ __forceinline__ void mem_attn_fast(const Frame& F, bf16_t* proj, int ldq, int qcol0, const float* qgain, const bf16_t* memkv) {
    LAS unsigned char* lds = F.lds + RING_OFF;
    const int lane = F.lane, lo = lane & 15, hi = lane >> 4;
    for (int unit = blockIdx.x; unit < 256; unit += F.G) {
        const int hm = unit & 3, tq = (unit >> 2) * 256;
        stage_kv_bf16(lds, memkv + hm * 64, memkv + 256 + hm * 64, 1024, F.tid);
        __syncthreads();
        const f32x4 ga0 = *(const f32x4*)(qgain + 8 * hi) * QSCALE, ga1 = *(const f32x4*)(qgain + 8 * hi + 4) * QSCALE, gb0 = *(const f32x4*)(qgain + 32 + 8 * hi) * QSCALE, gb1 = *(const f32x4*)(qgain + 32 + 8 * hi + 4) * QSCALE;
#pragma unroll 1
        for (int tt = 0; tt < 2; ++tt) {
            const int t = tq + 32 * F.wave + 16 * tt + lo;
            bf16_t* qp = proj + (size_t)t * ldq + qcol0 + hm * 64;
            const v4u ra = *(const v4u*)(qp + 8 * hi), rb = *(const v4u*)(qp + 32 + 8 * hi);
            f32x4 a0 = {__uint_as_float(ra.x << 16), __uint_as_float(ra.x & 0xffff0000u), __uint_as_float(ra.y << 16), __uint_as_float(ra.y & 0xffff0000u)};
            f32x4 a1 = {__uint_as_float(ra.z << 16), __uint_as_float(ra.z & 0xffff0000u), __uint_as_float(ra.w << 16), __uint_as_float(ra.w & 0xffff0000u)};
            f32x4 b0 = {__uint_as_float(rb.x << 16), __uint_as_float(rb.x & 0xffff0000u), __uint_as_float(rb.y << 16), __uint_as_float(rb.y & 0xffff0000u)};
            f32x4 b1 = {__uint_as_float(rb.z << 16), __uint_as_float(rb.z & 0xffff0000u), __uint_as_float(rb.w << 16), __uint_as_float(rb.w & 0xffff0000u)};
            const f32x4 sq = a0 * a0 + a1 * a1 + b0 * b0 + b1 * b1;
            float ss = (sq[0] + sq[1]) + (sq[2] + sq[3]);
            ss += __shfl_xor(ss, 16); ss += __shfl_xor(ss, 32);
            const float rs = rsqrtf(ss * (1.f / 64.f) + 1e-6f);
            a0 = a0 * ga0 * rs; a1 = a1 * ga1 * rs; b0 = b0 * gb0 * rs; b1 = b1 * gb1 * rs;
            v4u r0, r1;
            r0.x = cvtpk(a0[0], a0[1]); r0.y = cvtpk(a0[2], a0[3]); r0.z = cvtpk(a1[0], a1[1]); r0.w = cvtpk(a1[2], a1[3]);
            r1.x = cvtpk(b0[0], b0[1]); r1.y = cvtpk(b0[2], b0[3]); r1.z = cvtpk(b1[0], b1[1]); r1.w = cvtpk(b1[2], b1[3]);
            f32x4 o[4]; float l = 0.f;
#pragma unroll
            for (int dt = 0; dt < 4; ++dt) o[dt] = (f32x4){0.f, 0.f, 0.f, 0.f};
            attn_core<false, false>(lds, __builtin_bit_cast(bf16x8, r0), __builtin_bit_cast(bf16x8, r1), 8, 0.f, 0.f, lo, hi, o, l);
            l += __shfl_xor(l, 16); l += __shfl_xor(l, 32);
            const float inv = 1.f / l;
#pragma unroll
            for (int dt = 0; dt < 4; ++dt) *(u32x2*)(qp + 16 * dt + 4 * hi) = pack4(o[dt] * inv);
        }
        __syncthreads();
    }
}
struct MobaBuf { unsigned* cnt; unsigned short* list; unsigned char* nsel; bf16_t* slot0; bf16_t* slot1; bf16_t* slot2; float* lsl; };
__device__ __forceinline__ void top3_insert(float v, int i, float& v0, float& v1, float& v2, int& i0, int& i1, int& i2) {
    const bool b0 = v > v0 || (v == v0 && i < i0), b1 = v > v1 || (v == v1 && i < i1), b2 = v > v2 || (v == v2 && i < i2);
    v2 = b1 ? v1 : (b2 ? v : v2); i2 = b1 ? i1 : (b2 ? i : i2);
    v1 = b0 ? v0 : (b1 ? v : v1); i1 = b0 ? i0 : (b1 ? i : i1);
    v0 = b0 ? v : v0; i0 = b0 ? i : i0;
}
struct RouteSel { int i0, i1, i2; int p0, p1, p2; int t; };
__device__ __forceinline__ void moba_route(const Frame& F, bf16_t* proj, const float* qgain, const float* kgain, const float* kmean, const MobaBuf& B) {
    LAS unsigned char* lds = F.lds + RING_OFF;
    LAS int* cntL = (LAS int*)lds; LAS int* baseL = cntL + 64;
    const int lane = F.lane, lo = lane & 15, hi = lane >> 4;
    float kbound = fabsf(kgain[lane]), qbound = fabsf(qgain[lane]);
#pragma unroll
    for (int o = 1; o < 64; o <<= 1) { kbound = fmaxf(kbound, __shfl_xor(kbound, o)); qbound = fmaxf(qbound, __shfl_xor(qbound, o)); }
    kbound *= 8.0f * 1.02f * qbound;
    const f32x4 ga0 = *(const f32x4*)(qgain + 8 * hi), ga1 = *(const f32x4*)(qgain + 8 * hi + 4), gb0 = *(const f32x4*)(qgain + 32 + 8 * hi), gb1 = *(const f32x4*)(qgain + 32 + 8 * hi + 4);
    for (int u = blockIdx.x; u < 12 * 64; u += F.G) {
        const int h = u % 12, i_blk = u / 12;
        if (F.tid < 64) cntL[F.tid] = 0;
        __syncthreads();
        const float slope2 = exp2f(-8.0f * (float)(h + 1) / 12.0f) * 1.4426950408889634f;
        const int ntile = (i_blk + 15) >> 4;
        RouteSel R[2];
#pragma unroll
        for (int e = 0; e < 2; ++e) {
            const int t = i_blk * 256 + 32 * F.wave + 16 * e + lo;
            bf16_t* qp = proj + (size_t)t * 1024 + h * 64;
            const v4u ra = *(const v4u*)(qp + 8 * hi), rb = *(const v4u*)(qp + 32 + 8 * hi);
            f32x4 a0 = {__uint_as_float(ra.x << 16), __uint_as_float(ra.x & 0xffff0000u), __uint_as_float(ra.y << 16), __uint_as_float(ra.y & 0xffff0000u)};
            f32x4 a1 = {__uint_as_float(ra.z << 16), __uint_as_float(ra.z & 0xffff0000u), __uint_as_float(ra.w << 16), __uint_as_float(ra.w & 0xffff0000u)};
            f32x4 b0 = {__uint_as_float(rb.x << 16), __uint_as_float(rb.x & 0xffff0000u), __uint_as_float(rb.y << 16), __uint_as_float(rb.y & 0xffff0000u)};
            f32x4 b1 = {__uint_as_float(rb.z << 16), __uint_as_float(rb.z & 0xffff0000u), __uint_as_float(rb.w << 16), __uint_as_float(rb.w & 0xffff0000u)};
            const f32x4 sq = a0 * a0 + a1 * a1 + b0 * b0 + b1 * b1;
            float ss = (sq[0] + sq[1]) + (sq[2] + sq[3]);
            ss += __shfl_xor(ss, 16); ss += __shfl_xor(ss, 32);
            const float rs = rsqrtf(ss * (1.f / 64.f) + 1e-6f) * QSCALE;
            a0 = a0 * ga0 * rs; a1 = a1 * ga1 * rs; b0 = b0 * gb0 * rs; b1 = b1 * gb1 * rs;
            v4u h0, h1, l0, l1;
            h0.x = cvtpk(a0[0], a0[1]); h0.y = cvtpk(a0[2], a0[3]); h0.z = cvtpk(a1[0], a1[1]); h0.w = cvtpk(a1[2], a1[3]);
            h1.x = cvtpk(b0[0], b0[1]); h1.y = cvtpk(b0[2], b0[3]); h1.z = cvtpk(b1[0], b1[1]); h1.w = cvtpk(b1[2], b1[3]);
            {
                const f32x4 d0 = a0 - unpack4((u32x2){h0.x, h0.y}), d1 = a1 - unpack4((u32x2){h0.z, h0.w}), d2 = b0 - unpack4((u32x2){h1.x, h1.y}), d3 = b1 - unpack4((u32x2){h1.z, h1.w});
                l0.x = cvtpk(d0[0], d0[1]); l0.y = cvtpk(d0[2], d0[3]); l0.z = cvtpk(d1[0], d1[1]); l0.w = cvtpk(d1[2], d1[3]);
                l1.x = cvtpk(d2[0], d2[1]); l1.y = cvtpk(d2[2], d2[3]); l1.z = cvtpk(d3[0], d3[1]); l1.w = cvtpk(d3[2], d3[3]);
            }
            const bf16x8 qh0 = __builtin_bit_cast(bf16x8, h0), qh1 = __builtin_bit_cast(bf16x8, h1), ql0 = __builtin_bit_cast(bf16x8, l0), ql1 = __builtin_bit_cast(bf16x8, l1);
            *(v4u*)(qp + 8 * hi) = h0; *(v4u*)(qp + 32 + 8 * hi) = h1;
            float v0 = -INFINITY, v1 = -INFINITY, v2 = -INFINITY; int i0 = 0x7fffffff, i1 = 0x7fffffff, i2 = 0x7fffffff;
            f32x4 kf[4][4];
#pragma unroll
            for (int nt = 0; nt < 4; ++nt) {
                const float* kp = kmean + ((size_t)h * 64 + 16 * nt + lo) * 64 + 8 * hi;
#pragma unroll
                for (int j = 0; j < 4; ++j) kf[nt][j] = (f32x4){0.f, 0.f, 0.f, 0.f};
                if (nt < ntile) { kf[nt][0] = *(const f32x4*)(kp); kf[nt][1] = *(const f32x4*)(kp + 4); kf[nt][2] = *(const f32x4*)(kp + 32); kf[nt][3] = *(const f32x4*)(kp + 36); }
            }
#pragma unroll
            for (int nt = 0; nt < 4; ++nt) {
                if (nt < ntile) {
                    f32x4 acc = {0.f, 0.f, 0.f, 0.f};
#pragma unroll
                    for (int ks = 0; ks < 2; ++ks) {
                        const f32x4 k0 = kf[nt][2 * ks], k1 = kf[nt][2 * ks + 1];
                        v4u kh, kl; kh.x = cvtpk(k0[0], k0[1]); kh.y = cvtpk(k0[2], k0[3]); kh.z = cvtpk(k1[0], k1[1]); kh.w = cvtpk(k1[2], k1[3]);
                        const f32x4 e0 = k0 - unpack4((u32x2){kh.x, kh.y}), e1 = k1 - unpack4((u32x2){kh.z, kh.w});
                        kl.x = cvtpk(e0[0], e0[1]); kl.y = cvtpk(e0[2], e0[3]); kl.z = cvtpk(e1[0], e1[1]); kl.w = cvtpk(e1[2], e1[3]);
                        const bf16x8 kha = __builtin_bit_cast(bf16x8, kh), kla = __builtin_bit_cast(bf16x8, kl);
                        acc = MFMA16(kha, ks ? qh1 : qh0, acc); acc = MFMA16(kha, ks ? ql1 : ql0, acc); acc = MFMA16(kla, ks ? qh1 : qh0, acc);
                    }
#pragma unroll
                    for (int r = 0; r < 4; ++r) { const int n = 16 * nt + 4 * hi + r; if (n < i_blk) top3_insert(acc[r], n, v0, v1, v2, i0, i1, i2); }
                }
            }
#pragma unroll
            for (int o = 16; o <= 32; o <<= 1) {
                const float w0 = __shfl_xor(v0, o), w1 = __shfl_xor(v1, o), w2 = __shfl_xor(v2, o); const int j0 = __shfl_xor(i0, o), j1 = __shfl_xor(i1, o), j2 = __shfl_xor(i2, o);
                top3_insert(w0, j0, v0, v1, v2, i0, i1, i2); top3_insert(w1, j1, v0, v1, v2, i0, i1, i2); top3_insert(w2, j2, v0, v1, v2, i0, i1, i2);
            }
            const float smax = sqrtf(ss * (rs * rs)) * kbound;
            R[e].t = t; R[e].i0 = -1; R[e].i1 = -1; R[e].i2 = -1; R[e].p0 = 0; R[e].p1 = 0; R[e].p2 = 0;
            if (hi == 0) {
                if (v0 > -INFINITY && slope2 * (float)(t - 256 * i0 - 255) - smax <= 150.f) { R[e].i0 = i0; R[e].p0 = __hip_atomic_fetch_add((int*)(cntL + i0), 1, __ATOMIC_RELAXED, __HIP_MEMORY_SCOPE_WORKGROUP); }
                if (v1 > -INFINITY && slope2 * (float)(t - 256 * i1 - 255) - smax <= 150.f) { R[e].i1 = i1; R[e].p1 = __hip_atomic_fetch_add((int*)(cntL + i1), 1, __ATOMIC_RELAXED, __HIP_MEMORY_SCOPE_WORKGROUP); }
                if (v2 > -INFINITY && slope2 * (float)(t - 256 * i2 - 255) - smax <= 150.f) { R[e].i2 = i2; R[e].p2 = __hip_atomic_fetch_add((int*)(cntL + i2), 1, __ATOMIC_RELAXED, __HIP_MEMORY_SCOPE_WORKGROUP); }
            }
        }
        __syncthreads();
        if (F.tid < 64) { const int c = cntL[F.tid]; int b = 0; if (c > 0) b = (int)atomicAdd(B.cnt + h * 64 + F.tid, (unsigned)c); baseL[F.tid] = b; }
        __syncthreads();
        if (hi == 0) {
#pragma unroll
            for (int e = 0; e < 2; ++e) {
                int nl = 0; const int t = R[e].t;
                if (R[e].i0 >= 0) { B.list[(size_t)(h * 64 + R[e].i0) * 16384 + baseL[R[e].i0] + R[e].p0] = (unsigned short)(t | (nl << 14)); ++nl; }
                if (R[e].i1 >= 0) { B.list[(size_t)(h * 64 + R[e].i1) * 16384 + baseL[R[e].i1] + R[e].p1] = (unsigned short)(t | (nl << 14)); ++nl; }
                if (R[e].i2 >= 0) { B.list[(size_t)(h * 64 + R[e].i2) * 16384 + baseL[R[e].i2] + R[e].p2] = (unsigned short)(t | (nl << 14)); ++nl; }
                B.nsel[(size_t)t * 12 + h] = (unsigned char)nl;
            }
        }
        __syncthreads();
    }
}
__device__ __forceinline__ void moba_selected(const Frame& F, const bf16_t* proj, const bf16_t* KV, const MobaBuf& B) {
    LAS unsigned char* lds = F.lds + RING_OFF;
    LAS int* pfx = (LAS int*)(lds + L_APFX); LAS int* cntl = pfx + 772;
    const int lane = F.lane, lo = lane & 15, hi = lane >> 4;
    if (F.wave == 0) {
        int loc[12]; int s = 0;
#pragma unroll
        for (int j = 0; j < 12; ++j) { const int c = (int)__hip_atomic_load(B.cnt + lane * 12 + j, __ATOMIC_RELAXED, __HIP_MEMORY_SCOPE_AGENT); cntl[lane * 12 + j] = c; loc[j] = (c + 511) >> 9; s += loc[j]; }
        int inc = s;
#pragma unroll
        for (int o = 1; o < 64; o <<= 1) { const int v = __shfl_up(inc, o); if (lane >= o) inc += v; }
        int ex = inc - s;
#pragma unroll
        for (int j = 0; j < 12; ++j) { pfx[lane * 12 + j] = ex; ex += loc[j]; }
        if (lane == 63) pfx[768] = inc;
    }
    __syncthreads();
    const int total = pfx[768];
    KvRegs KR;
    int u = blockIdx.x, p = 0;
    if (u < total) { int a = 0, b = 768; while (b - a > 1) { const int m = (a + b) >> 1; if (pfx[m] <= u) a = m; else b = m; } p = a;
        kv_load(KR, KV + (size_t)((p & 63) * 256) * 1536 + (p >> 6) * 64, KV + (size_t)((p & 63) * 256) * 1536 + 768 + (p >> 6) * 64, 1536, F.tid); }
    for (; u < total; u += F.G) {
        const int h = p >> 6, n = p & 63, q0 = (u - pfx[p]) * 512;
        const int cnt = cntl[p];
        const int nq = min(512, cnt - q0);
        kv_write(KR, lds, F.tid);
        __syncthreads();
        const int un = u + F.G; int pn = p;
        if (un < total) { int a = p, b = 768; while (b - a > 1) { const int m = (a + b) >> 1; if (pfx[m] <= un) a = m; else b = m; } pn = a;
            kv_load(KR, KV + (size_t)((pn & 63) * 256) * 1536 + (pn >> 6) * 64, KV + (size_t)((pn & 63) * 256) * 1536 + 768 + (pn >> 6) * 64, 1536, F.tid); }
        const float slope2 = exp2f(-8.0f * (float)(h + 1) / 12.0f) * 1.4426950408889634f;
        const unsigned short* lst = B.list + (size_t)p * 16384 + q0;
        for (int tile = F.wave; 16 * tile < nq; tile += NWAVES) {
            const int qi = 16 * tile + lo; const bool ok = qi < nq;
            const unsigned e = lst[ok ? qi : 0];
            const int t = (int)(e & 0x3fffu), slot = (int)(e >> 14);
            const bf16_t* qp = proj + (size_t)t * 1024 + h * 64;
            const bf16x8 q0f = *(const bf16x8*)(qp + 8 * hi), q1f = *(const bf16x8*)(qp + 32 + 8 * hi);
            f32x4 o[4]; float l = 0.f;
#pragma unroll
            for (int dt = 0; dt < 4; ++dt) o[dt] = (f32x4){0.f, 0.f, 0.f, 0.f};
            attn_core<true, false>(lds, q0f, q1f, 8, slope2, (float)(t - n * 256), lo, hi, o, l);
            l += __shfl_xor(l, 16); l += __shfl_xor(l, 32);
            if (ok) {
                const long long d1 = (const char*)B.slot1 - (const char*)B.slot0, d2 = (const char*)B.slot2 - (const char*)B.slot0;
                bf16_t* sb = (bf16_t*)((char*)B.slot0 + (slot == 1 ? d1 : 0ll) + (slot == 2 ? d2 : 0ll));
                bf16_t* dst = sb + ((size_t)t * 12 + h) * 64 + 4 * hi;
#pragma unroll
                for (int dt = 0; dt < 4; ++dt) *(u32x2*)(dst + 16 * dt) = pack4(o[dt]);
                if (hi == 0) B.lsl[((size_t)t * 12 + h) * 3 + slot] = l;
            }
        }
        __syncthreads();
        p = pn;
    }
}
__device__ __forceinline__ void moba_own(const Frame& F, bf16_t* proj, const bf16_t* KV, const MobaBuf& B) {
    LAS unsigned char* lds = F.lds + RING_OFF;
    const int lane = F.lane, lo = lane & 15, hi = lane >> 4;
    KvRegs KR;
    int u = blockIdx.x;
    if (u < 768) kv_load(KR, KV + (size_t)((u & 63) * 256) * 1536 + (u >> 6) * 64, KV + (size_t)((u & 63) * 256) * 1536 + 768 + (u >> 6) * 64, 1536, F.tid);
    for (; u < 768; u += F.G) {
        const int h = u >> 6, ib = u & 63;
        kv_write(KR, lds, F.tid);
        __syncthreads();
        const int un = u + F.G;
        if (un < 768) kv_load(KR, KV + (size_t)((un & 63) * 256) * 1536 + (un >> 6) * 64, KV + (size_t)((un & 63) * 256) * 1536 + 768 + (un >> 6) * 64, 1536, F.tid);
        const float slope2 = exp2f(-8.0f * (float)(h + 1) / 12.0f) * 1.4426950408889634f;
#pragma unroll 1
        for (int tt = 0; tt < 2; ++tt) {
            const int tile = tt ? 15 - F.wave : F.wave, trel0 = 16 * tile;
            const int t = ib * 256 + trel0 + lo;
            bf16_t* qp = proj + (size_t)t * 1024 + h * 64;
            const bf16x8 q0f = *(const bf16x8*)(qp + 8 * hi), q1f = *(const bf16x8*)(qp + 32 + 8 * hi);
            const int ns = (int)B.nsel[(size_t)t * 12 + h];
            const size_t so = ((size_t)t * 12 + h) * 64 + 4 * hi;
            float ls = 0.f; u32x2 pa[4], pb[4], pc[4];
#pragma unroll
            for (int dt = 0; dt < 4; ++dt) { pa[dt] = (u32x2){0u, 0u}; pb[dt] = pa[dt]; pc[dt] = pa[dt]; }
            if (ns > 0) { ls += B.lsl[((size_t)t * 12 + h) * 3 + 0];
#pragma unroll
                for (int dt = 0; dt < 4; ++dt) pa[dt] = *(const u32x2*)(B.slot0 + so + 16 * dt); }
            if (ns > 1) { ls += B.lsl[((size_t)t * 12 + h) * 3 + 1];
#pragma unroll
                for (int dt = 0; dt < 4; ++dt) pb[dt] = *(const u32x2*)(B.slot1 + so + 16 * dt); }
            if (ns > 2) { ls += B.lsl[((size_t)t * 12 + h) * 3 + 2];
#pragma unroll
                for (int dt = 0; dt < 4; ++dt) pc[dt] = *(const u32x2*)(B.slot2 + so + 16 * dt); }
            f32x4 o[4]; float l = 0.f;
#pragma unroll
            for (int dt = 0; dt < 4; ++dt) o[dt] = (f32x4){0.f, 0.f, 0.f, 0.f};
            const int nkt = tile + 1;
            attn_core<true, true>(lds, q0f, q1f, (nkt + 1) >> 1, slope2, (float)(trel0 + lo), lo, hi, o, l);
            l += __shfl_xor(l, 16); l += __shfl_xor(l, 32);
            l += ls;
#pragma unroll
            for (int dt = 0; dt < 4; ++dt) o[dt] += unpack4(pa[dt]) + unpack4(pb[dt]) + unpack4(pc[dt]);
            const float inv = 1.f / l;
#pragma unroll
            for (int dt = 0; dt < 4; ++dt) *(u32x2*)(qp + 16 * dt + 4 * hi) = pack4(o[dt] * inv);
        }
        __syncthreads();
    }
}
__device__ __forceinline__ void mem_kv_direct(const Frame& F, const bf16_t* memb, const bf16_t* wmem, const float* rstd, bf16_t* memkv, const float* kgain, int t) {
    const int lane = F.lane, q = lane >> 4, n = lane & 15, row0 = (t & 15) * 16, ct = t >> 4, col0 = ct * 64;
    const bf16_t* ap = memb + (size_t)(row0 + n) * 1024 + 8 * q;
    const bf16_t* bp = wmem + (size_t)(col0 + n) * 1024 + 8 * q;
    f32x4 acc[4] = {{0.f, 0.f, 0.f, 0.f}, {0.f, 0.f, 0.f, 0.f}, {0.f, 0.f, 0.f, 0.f}, {0.f, 0.f, 0.f, 0.f}};
    bf16x8 A0[4], B0[4][4], A1[4], B1[4][4];
#define MKV_LOAD(A_, B_, k0) do { _Pragma("unroll") for (int s_ = 0; s_ < 4; ++s_) { A_[s_] = *(const bf16x8*)(ap + (k0) + 32 * s_); \
    _Pragma("unroll") for (int j_ = 0; j_ < 4; ++j_) B_[s_][j_] = *(const bf16x8*)(bp + (size_t)j_ * 16 * 1024 + (k0) + 32 * s_); } } while (0)
#define MKV_MMA(A_, B_) do { _Pragma("unroll") for (int s_ = 0; s_ < 4; ++s_) _Pragma("unroll") for (int j_ = 0; j_ < 4; ++j_) acc[j_] = MFMA16(A_[s_], B_[s_][j_], acc[j_]); } while (0)
    MKV_LOAD(A0, B0, 0);
#pragma unroll 1
    for (int k0 = 0; k0 < 1024; k0 += 256) {
        MKV_LOAD(A1, B1, k0 + 128);
        MKV_MMA(A0, B0);
        if (k0 + 256 < 1024) MKV_LOAD(A0, B0, k0 + 256);
        MKV_MMA(A1, B1);
    }
#undef MKV_LOAD
#undef MKV_MMA
    float sc[4];
#pragma unroll
    for (int r = 0; r < 4; ++r) sc[r] = rstd[row0 + 4 * q + r];
#pragma unroll
    for (int j = 0; j < 4; ++j)
#pragma unroll
        for (int r = 0; r < 4; ++r) acc[j][r] *= sc[r];
    if ((ct & 4) == 0) {
        const float* g = kgain + (ct >> 3) * 64;
        float ss[4];
#pragma unroll
        for (int r = 0; r < 4; ++r) { ss[r] = 0.f;
#pragma unroll
            for (int j = 0; j < 4; ++j) ss[r] += acc[j][r] * acc[j][r]; }
#pragma unroll
        for (int o = 1; o < 16; o <<= 1)
#pragma unroll
            for (int r = 0; r < 4; ++r) ss[r] += __shfl_xor(ss[r], o);
#pragma unroll
        for (int r = 0; r < 4; ++r) { const float inv = rsqrtf(ss[r] * (1.f / 64.f) + 1e-6f);
#pragma unroll
            for (int j = 0; j < 4; ++j) acc[j][r] *= inv * g[16 * j + n]; }
    }
#pragma unroll
    for (int j = 0; j < 4; ++j)
#pragma unroll
        for (int r = 0; r < 4; ++r) memkv[(size_t)(row0 + 4 * q + r) * 1024 + col0 + 16 * j + n] = f2bf_d(acc[j][r]);
}
__device__ __forceinline__ void mem_knorm_tile(const Frame& F, bf16_t* memkv, int col0, const float* gain) {
    const float g = gain[F.lane];
    for (int r0 = F.wave * 4; r0 < 256; r0 += NWAVES * 4) {
        bf16_t* rowp = memkv + (size_t)r0 * 1024 + col0 + F.lane;
        float v[4][4], ss[4][4];
#pragma unroll
        for (int j = 0; j < 4; ++j)
#pragma unroll
            for (int h = 0; h < 4; ++h) { v[j][h] = bf2f(rowp[(size_t)j * 1024 + h * 64]); ss[j][h] = v[j][h] * v[j][h]; }
#pragma unroll
        for (int o = 1; o < 64; o <<= 1)
#pragma unroll
            for (int j = 0; j < 4; ++j)
#pragma unroll
                for (int h = 0; h < 4; ++h) ss[j][h] += __shfl_xor(ss[j][h], o);
#pragma unroll
        for (int j = 0; j < 4; ++j)
#pragma unroll
            for (int h = 0; h < 4; ++h) rowp[(size_t)j * 1024 + h * 64] = f2bf_d(v[j][h] * rsqrtf(ss[j][h] * (1.f / 64.f) + 1e-6f) * g);
    }
}
#define GRID_BAR() xcd_barrier(bar)
#ifndef PROBE_A
#define PROBE_A -1
#define PROBE_B -1
#define PROBE_SCALE 0.1f
#endif
#define STAMP(i) do { if (PROBE_A >= 0 && blockIdx.x == 0 && threadIdx.x == 0) ((volatile unsigned long long*)(ctl + CW_TS))[i] = __builtin_amdgcn_s_memrealtime(); } while (0)
__global__ void __launch_bounds__(NWAVES * 64, 2) mega_fwd(Args args) {
    extern __shared__ __attribute__((aligned(16))) unsigned char lds_raw[];
    Frame F;
    F.lds = (LAS unsigned char*)lds_raw;
    F.tid = threadIdx.x; F.lane = F.tid & 63; F.wave = __builtin_amdgcn_readfirstlane(F.tid >> 6);
    F.G = gridDim.x; { const int bx = blockIdx.x; F.vcu = (F.G % 8 == 0) ? (bx % 8) * (F.G / 8) + bx / 8 : bx; }
    unsigned char* ws = args.ws;
    gu32* ctl = (gu32*)(ws + WS_CTL);
    for (int u = F.tid; u < (LDS_BYTES - LDSCTL_OFF) / 4; u += NWAVES * 64) ((LAS unsigned*)(F.lds + LDSCTL_OFF))[u] = 0u;
    __syncthreads();
    volatile LAS unsigned* MISC = (volatile LAS unsigned*)(F.lds + MISC_OFF);
    XcdBarrier bar = xcd_barrier_post((unsigned*)(ctl + CW_BAR) + args.bar_region * XCD_BAR_WORDS, MISC + 8);
    STAMP(0);
    const int lo = args.ph_lo, hi = args.ph_hi;
#define IN(k) (lo <= (k) && (k) < hi)
#define BOTH(k) (IN(k) && IN((k) + 1))
    const float* const* in = args.in;
    float* out = args.out;
    bf16_t* XB = (bf16_t*)(ws + WS_XB); bf16_t* BIG = (bf16_t*)(ws + WS_BIG); bf16_t* KVB = (bf16_t*)(ws + WS_KV);
    float* SSQ = (float*)(ws + WS_SSQ);
    const size_t FW = (size_t)1024 * 2752;

    bf16_t* WUP1 = (bf16_t*)(ws + WS_WF1); bf16_t* WDN1 = (bf16_t*)(ws + WS_WF1 + SZ_FFN_UP);
    bf16_t* WUP2 = (bf16_t*)(ws + WS_WF2); bf16_t* WDN2 = (bf16_t*)(ws + WS_WF2 + SZ_FFN_UP);
    bf16_t* WUP3 = (bf16_t*)((unsigned char*)out + 32 * MiB); bf16_t* WDN3 = (bf16_t*)(ws + WS_WIN1);
    const bool conv_in_p5 = (64 * 22) % F.G > 0;
    bf16_t* MEMKV = (bf16_t*)(ws + WS_MEMKV); bf16_t* MEMB = (bf16_t*)(ws + WS_MEMB); float* RSTDM = (float*)(ws + WS_MEMB + 512 * 1024); float* KMEAN = (float*)(ws + WS_KMEAN); float* KKINV = (float*)(ws + WS_KKINV); float* SBON = (float*)(ws + WS_SBON);
    bf16_t* W2T = (bf16_t*)(ws + WS_SMALLW); bf16_t* A2T = W2T + 768 * 64; bf16_t* G2T = A2T + 768 * 64;
    const RwkvW RW{in[17], in[18], in[20], in[23], in[24], in[25], in[26], in[27], W2T, A2T, G2T};
    const RwkvBuf RB{ws + WS_KV, ws + WS_KV + 24 * MiB, (unsigned char*)out, ws + WS_E, SBON};
    const PG8_LAS float* RT = (F.G % 8 == 0) ? (const PG8_LAS float*)(F.lds + RTAB_OFF) : (const PG8_LAS float*)nullptr; const int RBASE = 2048 * ((int)blockIdx.x & 7);
#define FILL_RT() do { if (RT) { for (int r_ = F.tid; r_ < 2048; r_ += NWAVES * 64) ((LAS float*)(F.lds + RTAB_OFF))[r_] = pg8::row_rstd(SSQ, RBASE + r_); __syncthreads(); } } while (0)
#define GEMM_UP(Aptr, Bptr, Ncols, EPI) do { pg8::Gemm g{Aptr, Bptr, M, Ncols, 1024, 1024}; pg8::StaticOrder S; S.init(M, Ncols, F.G, (int)blockIdx.x); \
        pg8::gemm_phase<decltype(EPI), pg8::StaticOrder, true, true>(F.lds + RING_OFF, g, S, EPI); } while (0)
#define GEMM_DOWN(Bptr, FINAL) do { pg8::Gemm g{BIG, Bptr, M, 1024, FFP, FFP}; pg8::StaticOrder S; S.init(M, 1024, F.G, (int)blockIdx.x); \
        pg8::EpiResid E{XB, SSQ, (FINAL) ? out : nullptr, 0.5f}; pg8::gemm_phase<pg8::EpiResid, pg8::StaticOrder, true, true>(F.lds + RING_OFF, g, S, E); } while (0)
#define GEMM_OUTPROJ(LDA, Bptr) do { pg8::Gemm g{BIG, Bptr, M, 1024, 1024, LDA}; pg8::StaticOrder S; S.init(M, 1024, F.G, (int)blockIdx.x); \
        pg8::EpiResid E{XB, SSQ, nullptr, 1.0f}; pg8::gemm_phase<pg8::EpiResid, pg8::StaticOrder, true, true>(F.lds + RING_OFF, g, S, E); } while (0)

    if (IN(0)) {
        conv_ffn(F, in[2], in[3], in[4], in[5], ws + WS_WF1);
        conv_matrix(F, in[16], 1024, 2816, in[6], (bf16_t*)(ws + WS_WIN1), 1024, 3);
        conv_matrix(F, in[19], 64, 768, nullptr, W2T, 64, 0); conv_matrix(F, in[21], 64, 768, nullptr, A2T, 64, 0); conv_matrix(F, in[22], 128, 768, nullptr, G2T, 128, 0);
        x_to_xb(F, in[0], XB, SSQ, M, false);
        x_to_xb(F, in[1], MEMB, RSTDM, 256, true);
        for (int i = (int)blockIdx.x * NWAVES * 64 + F.tid; i < 12 * 64 * 64; i += (int)F.G * NWAVES * 64) KMEAN[i] = 0.f;
        conv_matrix(F, in[9], 1024, 512, in[8], (bf16_t*)(ws + WS_WMEM), 1024, 0);
        conv_matrix(F, in[9] + (size_t)1024 * 512, 1024, 512, in[8] + 1024, (bf16_t*)(ws + WS_WMEM) + (size_t)512 * 1024, 1024, 0);
        if (BOTH(0)) GRID_BAR(); STAMP(1);
    }
#define TAIL_FILL(NUNITS, BODY) do { const int rem_ = (NUNITS) % F.G; if (rem_ > 0 && (int)blockIdx.x >= rem_) { Frame F2 = F; F2.vcu = (int)blockIdx.x - rem_; F2.G = F.G - rem_; BODY } } while (0)
    if (IN(1)) { FILL_RT(); pg8::EpiUpKV E{BIG, SSQ, nullptr, 0, RT, RBASE, 0, nullptr, nullptr}; GEMM_UP(XB, WUP1, 5632, E);
        TAIL_FILL(64 * 22, { conv_ffn(F2, in[12], in[13], in[14], in[15], ws + WS_WF2); });
        if (BOTH(1)) GRID_BAR(); STAMP(2); }
    if (IN(2)) { GEMM_DOWN(WDN1, false); if (BOTH(2)) GRID_BAR(); STAMP(3); }
    if (IN(3)) { FILL_RT(); pg8::EpiProj E{BIG, 2816, SSQ, RT, RBASE}; GEMM_UP(XB, (const bf16_t*)(ws + WS_WIN1), 2816, E);
        TAIL_FILL(64 * 11, {
            conv_matrix(F2, in[7], 1024, 1024, nullptr, (bf16_t*)(ws + WS_WOUT1), 1024, 0);
            conv_matrix(F2, in[29], 1024, 1536, in[28], (bf16_t*)(ws + WS_WKV), 1024, 4);
            conv_matrix(F2, in[31], 1024, 1024, in[6] + 1024, (bf16_t*)(ws + WS_WIN2), 1024, 0);
            conv_matrix(F2, in[7] + (size_t)1024 * 1024, 1024, 1024, nullptr, (bf16_t*)(ws + WS_WOUT2), 1024, 0); });
        if (BOTH(3)) GRID_BAR(); STAMP(4); }
    if (IN(4)) {
        rwkv_s1(F, BIG, RW, RB);
        if (BOTH(4)) GRID_BAR(); STAMP(5);
    }
    if (IN(5)) {
        rwkv_s2(F, RB);
        if (blockIdx.x >= S2_NWG && blockIdx.x < S2_NWG + 32)
            mem_kv_direct(F, MEMB, (const bf16_t*)(ws + WS_WMEM), RSTDM, MEMKV, in[11], ((int)blockIdx.x - S2_NWG) * 8 + F.wave);
        if (BOTH(5)) GRID_BAR(); STAMP(6); }
    if (IN(6)) { rwkv_s3(F, BIG, RW, RB); __syncthreads(); mem_attn_fast(F, BIG, 2816, 768, in[10], MEMKV); if (BOTH(6)) GRID_BAR(); STAMP(7); }
    if (IN(7)) { GEMM_OUTPROJ(2816, (const bf16_t*)(ws + WS_WOUT1)); if (BOTH(7)) GRID_BAR(); STAMP(8); }
    if (IN(8)) { FILL_RT(); pg8::EpiUpKV E{BIG, SSQ, nullptr, 0, RT, RBASE, 0, nullptr, nullptr}; GEMM_UP(XB, WUP2, 5632, E);
        TAIL_FILL(64 * 22, { conv_ffn(F2, in[2] + 1024, in[3] + FW, in[4] + FW, in[5] + FW, ws + WS_WF1);
                             conv_ffn(F2, in[12] + 1024, in[13] + FW, in[14] + FW, in[15] + FW, (unsigned char*)WUP3, (unsigned char*)WDN3); });
        if (BOTH(8)) GRID_BAR(); STAMP(9); }
    if (IN(9)) { GEMM_DOWN(WDN2, false); if (BOTH(9)) GRID_BAR(); STAMP(10); }
    if (IN(10)) { FILL_RT(); pg8::EpiUpKV E{BIG, SSQ, KVB, 6, RT, RBASE, 3, in[30], KMEAN}; GEMM_UP(XB, (const bf16_t*)(ws + WS_WKV), 7168, E); if (BOTH(10)) GRID_BAR(); STAMP(11); }
    if (IN(11)) { GEMM_DOWN(WDN1, false); if (BOTH(11)) GRID_BAR(); STAMP(12); }
    if (IN(12)) {
        if (!conv_in_p5) { conv_ffn(F, in[12] + 1024, in[13] + FW, in[14] + FW, in[15] + FW, (unsigned char*)WUP3, (unsigned char*)WDN3); __syncthreads(); }
        pg8::EpiProj E{BIG, 1024, SSQ, nullptr, 0}; GEMM_UP(XB, (const bf16_t*)(ws + WS_WIN2), 1024, E);
        if (BOTH(12)) GRID_BAR(); STAMP(13);
    }
    const MobaBuf MB{(unsigned*)(ctl + CW_CNT), (unsigned short*)(ws + WS_BIG + 32 * MiB), ws + WS_KKINV, (bf16_t*)(ws + WS_BIG + 56 * MiB), (bf16_t*)out, (bf16_t*)(ws + WS_E), (float*)(ws + WS_E + 24 * MiB)};
    if (IN(13)) {
        mem_attn_fast(F, BIG, 1024, 768, in[10] + 64, MEMKV + 512);
        __syncthreads(); STAMP(20);
        moba_route(F, BIG, in[32], in[30], KMEAN, MB);
        if (BOTH(13)) GRID_BAR(); STAMP(14);
        moba_selected(F, BIG, KVB, MB);
        GRID_BAR(); STAMP(15);
        moba_own(F, BIG, KVB, MB);
        GRID_BAR(); STAMP(16);
    }
    if (IN(14)) { GEMM_OUTPROJ(1024, (const bf16_t*)(ws + WS_WOUT2)); if (BOTH(14)) GRID_BAR(); STAMP(17); }
    if (IN(15)) { FILL_RT(); pg8::EpiUpKV E{BIG, SSQ, nullptr, 0, RT, RBASE, 0, nullptr, nullptr}; GEMM_UP(XB, WUP3, 5632, E); if (BOTH(15)) GRID_BAR(); STAMP(18); }
    if (IN(16)) { GEMM_DOWN(WDN3, true); }
    if (PROBE_A >= 0) { GRID_BAR(); STAMP(19);
        if (blockIdx.x == 0 && threadIdx.x == 0) { volatile unsigned long long* ts = (volatile unsigned long long*)(ctl + CW_TS); const float dt = (float)(ts[PROBE_B] - ts[PROBE_A]) * 0.01f; out[0] += dt * PROBE_SCALE; } }
#undef IN
#undef BOTH
}
}
static int mk_grid = 0;
static bool mk_setup() {
    if (mk_grid != 0) return mk_grid > 0;
    int dev = 0, cus = 0, per_cu = 0;
    if (hipGetDevice(&dev) != hipSuccess || hipDeviceGetAttribute(&cus, hipDeviceAttributeMultiprocessorCount, dev) != hipSuccess) { mk_grid = -1; return false; }
    if (hipFuncSetAttribute((const void*)mk::mega_fwd, hipFuncAttributeMaxDynamicSharedMemorySize, mk::LDS_BYTES) != hipSuccess) { fprintf(stderr, "hipFuncSetAttribute failed\n"); mk_grid = -1; return false; }
    if (hipOccupancyMaxActiveBlocksPerMultiprocessor(&per_cu, (const void*)mk::mega_fwd, mk::NWAVES * 64, mk::LDS_BYTES) != hipSuccess || per_cu < 1) { fprintf(stderr, "occupancy query: %d\n", per_cu); per_cu = 1; }
    (void)hipGetLastError();
    mk_grid = cus * 1;
    return true;
}
static void launch_mega(void* const* d_in, void* d_out, void* d_ws, hipStream_t s, int ph_lo, int ph_hi, int region) {
    if (!mk_setup()) return;
    mk::Args a{};
    for (int i = 0; i < 33; ++i) a.in[i] = (const float*)d_in[i];
    a.out = (float*)d_out; a.ws = (unsigned char*)d_ws; a.ph_lo = ph_lo; a.ph_hi = ph_hi; a.bar_region = region; a.pad = 0;
    void* kargs[] = {&a};
    hipError_t e = hipLaunchCooperativeKernel((const void*)mk::mega_fwd, dim3(mk_grid), dim3(mk::NWAVES * 64), kargs, mk::LDS_BYTES, s);
    if (e != hipSuccess) fprintf(stderr, "cooperative launch failed: %s (grid %d)\n", hipGetErrorString(e), mk_grid);
}
extern "C" void kernel_launch(void* const* d_in, const int* in_sizes, int n_in, void* d_out, int out_size, void* d_ws, size_t ws_size, hipStream_t stream) {
    (void)hipMemsetAsync((char*)d_ws + mk::WS_CTL, 0, mk::CTL_ZERO_BYTES, stream);
    launch_mega(d_in, d_out, d_ws, stream, 0, 17, 0);
}
```

```cpp
#include <hip/hip_runtime.h>
#include <cstdint>
#include <cstdio>
#include <cmath>

typedef unsigned short bf16_t;
__host__ __device__ __forceinline__ float bf2f(bf16_t b) { union { unsigned u; float f; } c; c.u = ((unsigned)b) << 16; return c.f; }
__host__ __device__ __forceinline__ bf16_t f2bf(float f) { union { unsigned u; float f; } c; c.f = f; const unsigned u = c.u; return (bf16_t)((u + 0x7fffu + ((u >> 16) & 1u)) >> 16); }
#define GAS __attribute__((address_space(1)))
#define LAS __attribute__((address_space(3)))
typedef unsigned v4u __attribute__((ext_vector_type(4)));
typedef float f32x4 __attribute__((ext_vector_type(4)));
typedef short bf16x8 __attribute__((ext_vector_type(8)));
typedef GAS unsigned gu32;
typedef GAS unsigned long long gu64;
#define RLX_AGENT __ATOMIC_RELAXED, __HIP_MEMORY_SCOPE_AGENT
#define LDS_WAIT() asm volatile("s_waitcnt lgkmcnt(0)" ::: "memory")
#define VM_WAIT() asm volatile("s_waitcnt vmcnt(0)" ::: "memory")
__device__ __forceinline__ unsigned long long rt() { return __builtin_amdgcn_s_memrealtime(); }

#define XB_TMO      128
#define XB_XCNT(j)  (256  + 64 * (j))
#define XB_XSUB(j)  (1280 + 64 * (j))
#define XB_XGEN(j)  (2304 + 64 * (j))
#define XB_TOP      3328
#define XB_TOPGEN   3392
#define XCD_BAR_WORDS 3456
#define XB_SPIN_CAP (1u << 18)

__device__ __forceinline__ unsigned xb_ld(unsigned* p)              { return __hip_atomic_load(p, __ATOMIC_RELAXED, __HIP_MEMORY_SCOPE_AGENT); }
__device__ __forceinline__ unsigned xb_add(unsigned* p, unsigned v) { return __hip_atomic_fetch_add(p, v, __ATOMIC_RELAXED, __HIP_MEMORY_SCOPE_AGENT); }
__device__ __forceinline__ unsigned xb_xcc_id() { return (unsigned)__builtin_amdgcn_s_getreg((3 << 11) | 20) & 0xFu; }
#define XB_SPIN(cond, bar) do { unsigned _sp = 0; while (cond) { __builtin_amdgcn_s_sleep(1); \
    if ((++_sp & 255u) == 0u) { if (xb_ld(&(bar)[XB_TMO])) break; if (_sp > XB_SPIN_CAP) { atomicAdd(&(bar)[XB_TMO], 1u); break; } } } } while (0)

struct XcdBarrier {
    unsigned* bar; unsigned x;
    volatile LAS unsigned* st;
};

__device__ __forceinline__ XcdBarrier xcd_barrier_post(unsigned* bar, volatile LAS unsigned* st) {
    XcdBarrier b; b.bar = bar; b.x = xb_xcc_id(); b.st = st;
    if (threadIdx.x == 0) (void)xb_add(&bar[XB_XCNT(b.x)], 1u);
    return b;
}
__device__ __forceinline__ void xcd_barrier_complete(unsigned* bar, unsigned x, unsigned& nloc, unsigned& nx) {
    const unsigned G = gridDim.x * gridDim.y * gridDim.z;
    unsigned sum, cnt, mine, sp = 0u;
    for (;;) {
        sum = 0u; cnt = 0u; mine = 0u;
#pragma unroll
        for (unsigned j = 0; j < 16; ++j) { const unsigned c = xb_ld(&bar[XB_XCNT(j)]); sum += c; cnt += (c > 0u) ? 1u : 0u; mine = (j == x) ? c : mine; }
        if (sum == G) break;
        __builtin_amdgcn_s_sleep(1);
        if ((++sp & 255u) == 0u) { if (xb_ld(&bar[XB_TMO])) break; if (sp > XB_SPIN_CAP) { atomicAdd(&bar[XB_TMO], 1u); break; } }
    }
    nloc = mine > 0u ? mine : 1u; nx = cnt > 0u ? cnt : 1u;
}

__device__ __forceinline__ void xcd_barrier(const XcdBarrier& b) {
    asm volatile("s_waitcnt vmcnt(0)" ::: "memory");
    __syncthreads();
    if (threadIdx.x == 0) {
        unsigned* bar = b.bar;
        __builtin_amdgcn_s_waitcnt(0);
        unsigned nloc = b.st[0], nx = b.st[1];
        if (nloc == 0u) { xcd_barrier_complete(bar, b.x, nloc, nx); b.st[0] = nloc; b.st[1] = nx; }
        const unsigned old = xb_add(&bar[XB_XSUB(b.x)], 1u);
        const unsigned gen = old / nloc;
        if (old + 1u == (gen + 1u) * nloc) {
            __builtin_amdgcn_fence(__ATOMIC_RELEASE, "agent");
            asm volatile("s_waitcnt vmcnt(0)" ::: "memory");
            const unsigned og = xb_add(&bar[XB_TOP], 1u);
            const unsigned tg = og / nx;
            if (og + 1u == (tg + 1u) * nx) xb_add(&bar[XB_TOPGEN], 1u);
            else XB_SPIN(xb_ld(&bar[XB_TOPGEN]) == tg, bar);
            __builtin_amdgcn_fence(__ATOMIC_ACQUIRE, "agent");
            xb_add(&bar[XB_XGEN(b.x)], 1u);
            asm volatile("s_waitcnt vmcnt(0)" ::: "memory");
        } else {
            XB_SPIN(xb_ld(&bar[XB_XGEN(b.x)]) == gen, bar);
            __builtin_amdgcn_fence(__ATOMIC_ACQUIRE, "agent");
            asm volatile("s_waitcnt vmcnt(0)" ::: "memory");
        }
    }
    __syncthreads();
}
namespace pg8 {
#define PG8_LAS __attribute__((address_space(3)))
typedef unsigned short bf16_t;
typedef short bf16x8 __attribute__((ext_vector_type(8)));
typedef float f32x4 __attribute__((ext_vector_type(4)));
typedef unsigned u32x4 __attribute__((ext_vector_type(4)));
constexpr int BM = 256, BK = 64, HALF = 128, HTB = HALF * BK * 2  , STAGE_BYTES = 8 * HTB, NXCD = 8, WGM = 8;

__host__ __device__ __forceinline__ int lds_byte(int r, int c) { const int st = (r >> 4) * 2 + (c >> 5), rr = r & 15, cc = c & 31, ob = rr * 64 + cc * 2; return st * 1024 + (ob ^ (((ob >> 9) & 1) << 5)); }
__host__ __device__ __forceinline__ void stage_rc(int b, int& R, int& C) { const int st = b / 1024, sb = b % 1024, swz = sb ^ (((sb >> 9) & 1) << 5); R = (st >> 1) * 16 + swz / 64; C = (st & 1) * 32 + (swz % 64) / 2; }
__host__ __device__ __forceinline__ int perm32(int rho) { const int n = rho >> 4, i = rho & 15; return 8 * (i >> 2) + 4 * n + (i & 3); }

struct Unit { int pm, pn; };
struct Gemm { const bf16_t* A; const bf16_t* Bt; int M, N, K, lda; };

struct StaticOrder {
    int nM, nN, nwg, G, c;
    __host__ __device__ void init(int M, int N, int G_, int c_) { nM = M / BM; nN = N / BM; nwg = nM * nN; G = G_; c = c_; }
    __host__ __device__ bool next(int i, Unit& u) const {
        const long L = (long)i * G + c; if (L >= nwg) return false;
        int wgid = (int)L; { const int q = nwg / NXCD, r = nwg % NXCD, xcd = wgid % NXCD, off = wgid / NXCD; wgid = (xcd < r ? xcd * (q + 1) : r * (q + 1) + (xcd - r) * q) + off; }
        const int nig = WGM * nN, gid = wgid / nig, fm = gid * WGM, gsz = (nM - fm) < WGM ? (nM - fm) : WGM;
        u.pm = fm + ((wgid % nig) % gsz); u.pn = (wgid % nig) / gsz; return true;
    }
    __device__ __forceinline__ void a_ready(const Unit&) const {}
    __device__ __forceinline__ void done(const Unit&) const {}
};

__device__ __forceinline__ unsigned cvt_pk_bf16(float lo, float hi) { unsigned r; asm volatile("v_cvt_pk_bf16_f32 %0, %1, %2" : "=v"(r) : "v"(lo), "v"(hi)); return r; }
__device__ __forceinline__ float row_rstd(const float* ssq, int row) {
    const f32x4* p = (const f32x4*)(ssq + (size_t)row * 16);
    const f32x4 a = p[0], b = p[1], c = p[2], d = p[3];
    const float s = ((a[0] + a[1]) + (a[2] + a[3])) + ((b[0] + b[1]) + (b[2] + b[3])) + ((c[0] + c[1]) + (c[2] + c[3])) + ((d[0] + d[1]) + (d[2] + d[3]));
    return rsqrtf(s * (1.0f / 1024.0f) + 1e-6f);
}
__device__ __forceinline__ float silu_mul(float a, float b) { return a * __builtin_amdgcn_rcpf(1.0f + __expf(-a)) * b; }

#define EPI_RSTD(row) (rt ? rt[(row) - rbase] : row_rstd(ssq, (row)))
struct EpiUpKV {
    static constexpr bool PERM = true, AFTER_DRAIN = false;
    bf16_t* act; const float* ssq; bf16_t* kv; int nkv; const PG8_LAS float* rt; int rbase;
    int nk; const float* kgain; float* kmean;
    __device__ __forceinline__ void operator()(const f32x4 (&acc)[2][2][4][2], const Unit& u, int wr, int wc, int fr, int fq) const {
        const int row0 = u.pm * BM + wr * 64 + fr;
        if (u.pn < nk) {
            const int h = 4 * u.pn + wc;
            float g[2][8], cm[2][8];
#pragma unroll
            for (int bj = 0; bj < 2; ++bj)
#pragma unroll
                for (int e = 0; e < 8; ++e) { g[bj][e] = kgain[32 * bj + 8 * fq + e]; cm[bj][e] = 0.f; }
#pragma unroll
            for (int ai = 0; ai < 2; ++ai)
#pragma unroll
                for (int m = 0; m < 4; ++m) { const int row = row0 + ai * HALF + m * 16; const float s = EPI_RSTD(row);
                    f32x4 v[2][2]; float q = 0.f;
#pragma unroll
                    for (int bj = 0; bj < 2; ++bj)
#pragma unroll
                        for (int n = 0; n < 2; ++n) { v[bj][n] = acc[ai][bj][m][n] * s; q += (v[bj][n][0] * v[bj][n][0] + v[bj][n][1] * v[bj][n][1]) + (v[bj][n][2] * v[bj][n][2] + v[bj][n][3] * v[bj][n][3]); }
                    q += __shfl_xor(q, 16); q += __shfl_xor(q, 32);
                    const float inv = rsqrtf(q * (1.f / 64.f) + 1e-6f);
                    bf16_t* rowp = kv + (size_t)row * 1536 + 64 * h + 8 * fq;
#pragma unroll
                    for (int bj = 0; bj < 2; ++bj) { float o[8];
#pragma unroll
                        for (int e = 0; e < 8; ++e) { o[e] = v[bj][e >> 2][e & 3] * inv * g[bj][e]; cm[bj][e] += o[e]; }
                        u32x4 w; w.x = cvt_pk_bf16(o[0], o[1]); w.y = cvt_pk_bf16(o[2], o[3]); w.z = cvt_pk_bf16(o[4], o[5]); w.w = cvt_pk_bf16(o[6], o[7]);
                        *(u32x4*)(rowp + 32 * bj) = w; } }
#pragma unroll
            for (int bj = 0; bj < 2; ++bj)
#pragma unroll
                for (int e = 0; e < 8; ++e) { float x = cm[bj][e]; x += __shfl_xor(x, 1); x += __shfl_xor(x, 2); x += __shfl_xor(x, 4); x += __shfl_xor(x, 8);
                    if (fr == 0) unsafeAtomicAdd(kmean + ((size_t)(h * 64 + u.pm)) * 64 + 32 * bj + 8 * fq + e, x * (1.f / 256.f)); }
        } else if (u.pn < nkv) {
            const int col0 = u.pn * BM + wc * 32 + 8 * fq;
#pragma unroll
            for (int ai = 0; ai < 2; ++ai)
#pragma unroll
                for (int m = 0; m < 4; ++m) { const int row = row0 + ai * HALF + m * 16; const float s = EPI_RSTD(row); bf16_t* rowp = kv + (size_t)row * 1536 + col0;
#pragma unroll
                    for (int bj = 0; bj < 2; ++bj) { const f32x4 v0 = acc[ai][bj][m][0] * s, v1 = acc[ai][bj][m][1] * s; u32x4 w;
                        w.x = cvt_pk_bf16(v0[0], v0[1]); w.y = cvt_pk_bf16(v0[2], v0[3]); w.z = cvt_pk_bf16(v1[0], v1[1]); w.w = cvt_pk_bf16(v1[2], v1[3]);
                        *(u32x4*)(rowp + bj * HALF) = w; } }
        } else {
            const int col0 = (u.pn - nkv) * HALF + wc * 32 + 8 * fq;
#pragma unroll
            for (int ai = 0; ai < 2; ++ai)
#pragma unroll
                for (int m = 0; m < 4; ++m) { const int row = row0 + ai * HALF + m * 16; const float s = EPI_RSTD(row);
                    const f32x4 a0 = acc[ai][0][m][0] * s, a1 = acc[ai][0][m][1] * s, b0 = acc[ai][1][m][0] * s, b1 = acc[ai][1][m][1] * s; u32x4 w;
                    w.x = cvt_pk_bf16(silu_mul(a0[0], b0[0]), silu_mul(a0[1], b0[1])); w.y = cvt_pk_bf16(silu_mul(a0[2], b0[2]), silu_mul(a0[3], b0[3]));
                    w.z = cvt_pk_bf16(silu_mul(a1[0], b1[0]), silu_mul(a1[1], b1[1])); w.w = cvt_pk_bf16(silu_mul(a1[2], b1[2]), silu_mul(a1[3], b1[3]));
                    *(u32x4*)(act + (size_t)row * 2816 + col0) = w; }
        }
    }
};
struct EpiProj {
    static constexpr bool PERM = true, AFTER_DRAIN = false;
    bf16_t* O; int ldc; const float* ssq; const PG8_LAS float* rt; int rbase;
    __device__ __forceinline__ void operator()(const f32x4 (&acc)[2][2][4][2], const Unit& u, int wr, int wc, int fr, int fq) const {
        const int row0 = u.pm * BM + wr * 64 + fr, col0 = u.pn * BM + wc * 32 + 8 * fq;
#pragma unroll
        for (int ai = 0; ai < 2; ++ai)
#pragma unroll
            for (int m = 0; m < 4; ++m) { const int row = row0 + ai * HALF + m * 16; const float s = EPI_RSTD(row); bf16_t* rowp = O + (size_t)row * ldc + col0;
#pragma unroll
                for (int bj = 0; bj < 2; ++bj) { const f32x4 v0 = acc[ai][bj][m][0] * s, v1 = acc[ai][bj][m][1] * s; u32x4 w;
                    w.x = cvt_pk_bf16(v0[0], v0[1]); w.y = cvt_pk_bf16(v0[2], v0[3]); w.z = cvt_pk_bf16(v1[0], v1[1]); w.w = cvt_pk_bf16(v1[2], v1[3]);
                    *(u32x4*)(rowp + bj * HALF) = w; } }
    }
};
struct EpiResid {
    static constexpr bool PERM = true, AFTER_DRAIN = false;
    bf16_t* xb; float* ssq_out; float* outf; float scale;
    __device__ __forceinline__ void operator()(const f32x4 (&acc)[2][2][4][2], const Unit& u, int wr, int wc, int fr, int fq) const {
        const int col0 = u.pn * BM + wc * 32 + 8 * fq;
#pragma unroll
        for (int ai = 0; ai < 2; ++ai) {
            u32x4 pre[4][2];
#pragma unroll
            for (int m = 0; m < 4; ++m) { const size_t off = (size_t)(u.pm * BM + ai * HALF + wr * 64 + m * 16 + fr) * 1024 + col0;
#pragma unroll
                for (int bj = 0; bj < 2; ++bj) pre[m][bj] = *(const u32x4*)(xb + off + bj * HALF); }
#pragma unroll
            for (int m = 0; m < 4; ++m) { const int row = u.pm * BM + ai * HALF + wr * 64 + m * 16 + fr; const size_t off = (size_t)row * 1024 + col0; float q = 0.f;
#pragma unroll
                for (int bj = 0; bj < 2; ++bj) { const u32x4 p = pre[m][bj];
                    const f32x4 x0 = {__uint_as_float(p.x << 16), __uint_as_float(p.x & 0xffff0000u), __uint_as_float(p.y << 16), __uint_as_float(p.y & 0xffff0000u)};
                    const f32x4 x1 = {__uint_as_float(p.z << 16), __uint_as_float(p.z & 0xffff0000u), __uint_as_float(p.w << 16), __uint_as_float(p.w & 0xffff0000u)};
                    const f32x4 o0 = x0 + acc[ai][bj][m][0] * scale, o1 = x1 + acc[ai][bj][m][1] * scale;
                    if (outf) { *(f32x4*)(outf + off + bj * HALF) = o0; *(f32x4*)(outf + off + bj * HALF + 4) = o1; }
                    else { u32x4 w; w.x = cvt_pk_bf16(o0[0], o0[1]); w.y = cvt_pk_bf16(o0[2], o0[3]); w.z = cvt_pk_bf16(o1[0], o1[1]); w.w = cvt_pk_bf16(o1[2], o1[3]);
                           *(u32x4*)(xb + off + bj * HALF) = w;
                           const f32x4 r0 = {__uint_as_float(w.x << 16), __uint_as_float(w.x & 0xffff0000u), __uint_as_float(w.y << 16), __uint_as_float(w.y & 0xffff0000u)};
                           const f32x4 r1 = {__uint_as_float(w.z << 16), __uint_as_float(w.z & 0xffff0000u), __uint_as_float(w.w << 16), __uint_as_float(w.w & 0xffff0000u)};
                           q += ((r0[0] * r0[0] + r0[1] * r0[1]) + (r0[2] * r0[2] + r0[3] * r0[3])) + ((r1[0] * r1[0] + r1[1] * r1[1]) + (r1[2] * r1[2] + r1[3] * r1[3])); } }
                if (!outf) { q += __shfl_xor(q, 16); q += __shfl_xor(q, 32); if (fq == 0) ssq_out[(size_t)row * 16 + u.pn * 4 + wc] = q; } }
            asm volatile("" ::: "memory");
        }
    }
};
struct EpiMem {
    static constexpr bool PERM = true, AFTER_DRAIN = false;
    bf16_t* O; const float* rstd;
    __device__ __forceinline__ void operator()(const f32x4 (&acc)[2][2][4][2], const Unit& u, int wr, int wc, int fr, int fq) const {
        const int row0 = wr * 64 + fr, col0 = u.pn * BM + wc * 32 + 8 * fq;
#pragma unroll
        for (int ai = 0; ai < 2; ++ai)
#pragma unroll
            for (int m = 0; m < 4; ++m) { const int row = row0 + ai * HALF + m * 16; const float s = rstd[row]; bf16_t* rowp = O + (size_t)row * 1024 + col0;
#pragma unroll
                for (int bj = 0; bj < 2; ++bj) { const f32x4 v0 = acc[ai][bj][m][0] * s, v1 = acc[ai][bj][m][1] * s; u32x4 w;
                    w.x = cvt_pk_bf16(v0[0], v0[1]); w.y = cvt_pk_bf16(v0[2], v0[3]); w.z = cvt_pk_bf16(v1[0], v1[1]); w.w = cvt_pk_bf16(v1[2], v1[3]);
                    *(u32x4*)(rowp + bj * HALF) = w; } }
    }
};
struct OneUnitOrder {
    int pn;
    __device__ __forceinline__ bool next(int i, Unit& u) const { if (i > 0) return false; u.pm = 0; u.pn = pn; return true; }
    __device__ __forceinline__ void a_ready(const Unit&) const {}
    __device__ __forceinline__ void done(const Unit&) const {}
};
template <class Epi, class Sched, bool ALIGN_EPI = false, bool SP2 = false>
__device__ __forceinline__ void gemm_phase(PG8_LAS unsigned char* lds, const Gemm g, const Sched& S, const Epi& E) {
    const int tid = threadIdx.x, wid = __builtin_amdgcn_readfirstlane(tid >> 6), lane = tid & 63, wr = wid >> 2, wc = wid & 3, fr = lane & 15, fq = lane >> 4;
    const int K = g.K, nt = K / BK;
    unsigned voffA[2], voffB[2];
#pragma unroll
    for (int i = 0; i < 2; ++i) { int R, C; stage_rc(tid * 16 + i * 8192, R, C); const int Rb = Epi::PERM ? ((R & ~31) + perm32(R & 31)) : R;
        voffA[i] = (unsigned)(R * g.lda + C) * 2u; voffB[i] = (unsigned)(Rb * K + C) * 2u; }
    const size_t kstep = (size_t)(BK * 2);
    const size_t hstepB = (size_t)HALF * K * 2, hstepA = (size_t)HALF * g.lda * 2;
    const size_t tstepB = 2 * hstepB, tstepA = 2 * hstepA;
    const unsigned ldsw = (unsigned)wid * 1024u;
    const int aoff = lds_byte(wr * 64 + fr, fq * 8), boff = lds_byte(wc * 32 + fr, fq * 8);
#define PG8_SA(b, h) (((b) * 2 + (h)) * HTB)
#define PG8_SB(b, h) ((4 + (b) * 2 + (h)) * HTB)
#define PG8_STAGE(bufoff, gbase, voff) do { _Pragma("unroll") for (int _i = 0; _i < 2; ++_i) \
        __builtin_amdgcn_global_load_lds((const unsigned*)((const char*)(gbase) + (voff)[_i]), (PG8_LAS unsigned*)(lds + (bufoff) + ldsw + _i * 8192), 16, 0, 0); } while (0)
#define PG8_LDA(dst, b, h) do { _Pragma("unroll") for (int m = 0; m < 4; ++m) _Pragma("unroll") for (int k = 0; k < 2; ++k) dst[m][k] = *(const PG8_LAS bf16x8*)(lds + PG8_SA(b, h) + aoff + m * 2048 + k * 1024); } while (0)
#define PG8_LDB(dst, b, h) do { _Pragma("unroll") for (int n = 0; n < 2; ++n) _Pragma("unroll") for (int k = 0; k < 2; ++k) dst[n][k] = *(const PG8_LAS bf16x8*)(lds + PG8_SB(b, h) + boff + n * 2048 + k * 1024); } while (0)
#define PG8_MMA(ai, bj, At, Bt) do { __builtin_amdgcn_s_setprio(1); _Pragma("unroll") for (int m = 0; m < 4; ++m) _Pragma("unroll") for (int n = 0; n < 2; ++n) _Pragma("unroll") for (int k = 0; k < 2; ++k) \
        acc[ai][bj][m][n] = __builtin_amdgcn_mfma_f32_16x16x32_bf16(Bt[n][k], At[m][k], acc[ai][bj][m][n], 0, 0, 0); __builtin_amdgcn_s_setprio(0); } while (0)
#define PG8_WAIT_V(n) asm volatile("s_waitcnt vmcnt(" #n ")" ::: "memory")
#define PG8_WAIT_L(n) asm volatile("s_waitcnt lgkmcnt(" #n ")" ::: "memory")
#define PG8_BAR __builtin_amdgcn_s_barrier()
#define PG8_SCHED __builtin_amdgcn_sched_barrier(0)
    Unit cur, nxt; int ui = 0;
    if (!S.next(0, cur)) return;
    f32x4 acc[2][2][4][2];
#pragma unroll
    for (int a = 0; a < 2; ++a)
#pragma unroll
        for (int b = 0; b < 2; ++b)
#pragma unroll
            for (int m = 0; m < 4; ++m)
#pragma unroll
                for (int n = 0; n < 2; ++n) acc[a][b][m][n] = (f32x4){0.f, 0.f, 0.f, 0.f};
    bf16x8 At[4][2], B0[2][2], B1[2][2];
    const char* cA = (const char*)g.A + (size_t)cur.pm * tstepA; const char* cB = (const char*)g.Bt + (size_t)cur.pn * tstepB;
    S.a_ready(cur);
    if constexpr (SP2) {
        PG8_STAGE(PG8_SB(0, 0), cB, voffB); PG8_STAGE(PG8_SB(0, 1), cB + hstepB, voffB); PG8_STAGE(PG8_SA(0, 0), cA, voffA); PG8_STAGE(PG8_SA(0, 1), cA + hstepA, voffA);
        if (wr == 1) PG8_BAR;
        PG8_WAIT_V(2); PG8_BAR;
        PG8_STAGE(PG8_SB(1, 0), cB + kstep, voffB); PG8_STAGE(PG8_SA(1, 0), cA + kstep, voffA); PG8_STAGE(PG8_SB(1, 1), cB + hstepB + kstep, voffB);
        PG8_WAIT_V(6); PG8_BAR;
    } else {
        PG8_STAGE(PG8_SB(0, 0), cB, voffB); PG8_STAGE(PG8_SA(0, 0), cA, voffA); PG8_STAGE(PG8_SB(0, 1), cB + hstepB, voffB); PG8_STAGE(PG8_SA(0, 1), cA + hstepA, voffA);
        if (wr == 1) PG8_BAR;
        PG8_WAIT_V(4); PG8_BAR;
        PG8_STAGE(PG8_SB(1, 0), cB + kstep, voffB); PG8_STAGE(PG8_SA(1, 0), cA + kstep, voffA); PG8_STAGE(PG8_SB(1, 1), cB + hstepB + kstep, voffB);
        PG8_WAIT_V(6); PG8_BAR;
    }
    for (;;) {
        const bool has_next = S.next(ui + 1, nxt);
        const char* nA = has_next ? (const char*)g.A + (size_t)nxt.pm * tstepA : cA; const char* nB = has_next ? (const char*)g.Bt + (size_t)nxt.pn * tstepB : cB;
        for (int t = 0; t < nt; t += 2) {
            const bool last = (t == nt - 2);
            const char* a1 = cA + (size_t)(t + 1) * kstep;
            const char* a2 = last ? nA : cA + (size_t)(t + 2) * kstep; const char* b2 = last ? nB : cB + (size_t)(t + 2) * kstep;
            const char* a3 = a2 + kstep; const char* b3 = b2 + kstep;
            if (last && has_next) S.a_ready(nxt);
            if constexpr (SP2) {
            PG8_LDB(B0, 0, 0); PG8_LDB(B1, 0, 1); PG8_SCHED; PG8_LDA(At, 0, 0); PG8_STAGE(PG8_SA(1, 1), a1 + hstepA, voffA);
            PG8_WAIT_V(8); PG8_WAIT_L(0); PG8_BAR; PG8_MMA(0, 0, At, B0); PG8_MMA(0, 1, At, B1); PG8_BAR; PG8_SCHED;
            PG8_LDA(At, 0, 1); PG8_STAGE(PG8_SB(0, 0), b2, voffB); PG8_STAGE(PG8_SB(0, 1), b2 + hstepB, voffB); PG8_STAGE(PG8_SA(0, 0), a2, voffA);
            PG8_WAIT_V(8); PG8_WAIT_L(0); PG8_BAR; PG8_MMA(1, 0, At, B0); PG8_MMA(1, 1, At, B1); PG8_BAR; PG8_SCHED;
            PG8_LDB(B0, 1, 0); PG8_LDB(B1, 1, 1); PG8_SCHED; PG8_LDA(At, 1, 0); PG8_STAGE(PG8_SA(0, 1), a2 + hstepA, voffA);
            PG8_WAIT_V(8); PG8_WAIT_L(0); PG8_BAR; PG8_MMA(0, 0, At, B0); PG8_MMA(0, 1, At, B1); PG8_BAR; PG8_SCHED;
            PG8_LDA(At, 1, 1); PG8_STAGE(PG8_SB(1, 0), b3, voffB); PG8_STAGE(PG8_SB(1, 1), b3 + hstepB, voffB); PG8_STAGE(PG8_SA(1, 0), a3, voffA);
            PG8_WAIT_V(8); PG8_WAIT_L(0); PG8_BAR; PG8_MMA(1, 0, At, B0); PG8_MMA(1, 1, At, B1); PG8_BAR; PG8_SCHED;
            } else {
            PG8_LDB(B0, 0, 0); PG8_SCHED; PG8_LDA(At, 0, 0); PG8_STAGE(PG8_SA(1, 1), a1 + hstepA, voffA);
            PG8_WAIT_L(8); PG8_BAR; PG8_WAIT_L(0); PG8_MMA(0, 0, At, B0); PG8_BAR; PG8_SCHED;
            PG8_LDB(B1, 0, 1); PG8_STAGE(PG8_SB(0, 0), b2, voffB);
            PG8_BAR; PG8_WAIT_L(0); PG8_MMA(0, 1, At, B1); PG8_BAR;
            PG8_LDA(At, 0, 1); PG8_STAGE(PG8_SA(0, 0), a2, voffA);
            PG8_BAR; PG8_WAIT_L(0); PG8_MMA(1, 0, At, B0); PG8_BAR; PG8_SCHED;
            PG8_STAGE(PG8_SB(0, 1), b2 + hstepB, voffB);
            PG8_WAIT_V(6); PG8_BAR; PG8_MMA(1, 1, At, B1); PG8_BAR;
            PG8_LDB(B0, 1, 0); PG8_SCHED; PG8_LDA(At, 1, 0); PG8_STAGE(PG8_SA(0, 1), a2 + hstepA, voffA);
            PG8_WAIT_L(8); PG8_BAR; PG8_WAIT_L(0); PG8_MMA(0, 0, At, B0); PG8_BAR; PG8_SCHED;
            PG8_LDB(B1, 1, 1); PG8_STAGE(PG8_SB(1, 0), b3, voffB);
            PG8_BAR; PG8_WAIT_L(0); PG8_MMA(0, 1, At, B1); PG8_BAR;
            PG8_LDA(At, 1, 1); PG8_STAGE(PG8_SA(1, 0), a3, voffA);
            PG8_BAR; PG8_WAIT_L(0); PG8_MMA(1, 0, At, B0); PG8_BAR; PG8_SCHED;
            PG8_STAGE(PG8_SB(1, 1), b3 + hstepB, voffB);
            PG8_WAIT_V(6); PG8_BAR; PG8_MMA(1, 1, At, B1); PG8_BAR;
            }
        }
        if constexpr (ALIGN_EPI) { if (wr == 0) PG8_BAR; }
        if constexpr (!Epi::AFTER_DRAIN) { E(acc, cur, wr, wc, fr, fq); S.done(cur); }
        if (!has_next) break;
#pragma unroll
        for (int a = 0; a < 2; ++a)
#pragma unroll
            for (int b = 0; b < 2; ++b)
#pragma unroll
                for (int m = 0; m < 4; ++m)
#pragma unroll
                    for (int n = 0; n < 2; ++n) acc[a][b][m][n] = (f32x4){0.f, 0.f, 0.f, 0.f};
        cur = nxt; cA = nA; cB = nB; ++ui;
        if constexpr (ALIGN_EPI) { if (wr == 1) PG8_BAR; }
    }
    PG8_WAIT_V(0);
    if constexpr (!ALIGN_EPI) { if (wr == 0) PG8_BAR; }
    PG8_BAR;
    if constexpr (Epi::AFTER_DRAIN) { E.fused(acc, cur, wr, wc, fr, fq, lds, wid, lane); S.done(cur); }
#undef PG8_SA
#undef PG8_SB
#undef PG8_STAGE
#undef PG8_LDA
#undef PG8_LDB
#undef PG8_MMA
#undef PG8_WAIT_V
#undef PG8_WAIT_L
#undef PG8_BAR
#undef PG8_SCHED
}
}
namespace mk {
constexpr int NWAVES = 8;
constexpr int M = 16384, D = 1024, FF = 2752, FFP = 2816, AW = 2816, NH = 12, MIXW = 768, KVW = 1536;
constexpr size_t MiB = 1u << 20;
constexpr size_t WS_CTL = 0, CTL_ZERO_BYTES = 1 * MiB;
constexpr size_t WS_SSQ = 1 * MiB;
constexpr size_t WS_MEMKV = 2 * MiB;
constexpr size_t WS_KMEAN = 3 * MiB;
constexpr size_t WS_KKINV = 4 * MiB;
constexpr size_t WS_SBON = 5 * MiB;
constexpr size_t WS_SMALLW = 6 * MiB;
constexpr size_t WS_MEMB = 7 * MiB;
constexpr size_t SZ_FFN_UP = (size_t)5632 * 1024 * 2, SZ_FFN_DN = (size_t)1024 * 2816 * 2, SZ_FFN = SZ_FFN_UP + SZ_FFN_DN;
constexpr size_t WS_WKV = 8 * MiB;
constexpr size_t WS_WF1 = WS_WKV + (size_t)1536 * 1024 * 2;
constexpr size_t WS_WF2 = WS_WF1 + SZ_FFN;
constexpr size_t WS_WIN1 = WS_WF2 + SZ_FFN;
constexpr size_t WS_WOUT1 = WS_WIN1 + (size_t)2816 * 1024 * 2;
constexpr size_t WS_WOUT2 = WS_WOUT1 + (size_t)1024 * 1024 * 2;
constexpr size_t WS_WIN2 = WS_WOUT2 + (size_t)1024 * 1024 * 2;
constexpr size_t WS_WEND = WS_WIN2 + (size_t)1024 * 1024 * 2;
static_assert(WS_WEND <= 56 * MiB, "weights");
constexpr size_t WS_XB = 56 * MiB;
constexpr size_t WS_BIG = 88 * MiB;
constexpr size_t WS_KV = 176 * MiB;
constexpr size_t WS_E = 224 * MiB;
constexpr size_t WS_WMEM = WS_E + 28 * MiB;
constexpr size_t WS_END = 256 * MiB;
constexpr int CW_BAR = 4096;
constexpr int CW_CNT = 8192;
constexpr int CW_TS = 10240;

constexpr int RING_OFF = 0, RING_BYTES = 131072;
constexpr int LDSCTL_OFF = RING_BYTES, MISC_OFF = LDSCTL_OFF + 320;
constexpr int RTAB_OFF = LDSCTL_OFF + 1024;
constexpr int LDS_BYTES = 147456;
static_assert(RTAB_OFF + 8192 <= LDS_BYTES, "LDS map");

struct Args { const float* in[33]; float* out; unsigned char* ws; int ph_lo, ph_hi, bar_region, pad; };

struct Frame {
    LAS unsigned char* lds;
    int tid, lane, wave, vcu, G;
};

__device__ __forceinline__ float wave_sum(float v) {
#pragma unroll
    for (int o = 1; o < 64; o <<= 1) v += __shfl_xor(v, o);
    return v;
}
typedef float f32x2_t __attribute__((ext_vector_type(2))); typedef __bf16 bf16x2_t __attribute__((ext_vector_type(2)));
__device__ __forceinline__ unsigned cvtpk(float lo, float hi) { f32x2_t v = {lo, hi}; bf16x2_t b = __builtin_convertvector(v, bf16x2_t); return __builtin_bit_cast(unsigned, b); }
__device__ __forceinline__ unsigned pk2(float lo, float hi) { return cvtpk(lo, hi); }
__device__ __forceinline__ bf16_t f2bf_d(float f) { return (bf16_t)(cvtpk(f, f) & 0xffffu); }

__device__ __forceinline__ void conv_item(const float* __restrict__ W, int N, const float* __restrict__ gain, bf16_t* dst, int ldd, int rowbase, LAS float* scr, int k0, int n0, int lane) {
    const int r8 = lane >> 3, c4 = (lane & 7) * 4;
    f32x4 v[8];
#pragma unroll
    for (int i = 0; i < 8; ++i) v[i] = __builtin_nontemporal_load((const f32x4*)(W + (size_t)(k0 + 8 * i + r8) * N + n0 + c4));
#pragma unroll
    for (int i = 0; i < 8; ++i) { const int kk = 8 * i + r8; const float g = gain ? gain[k0 + kk] : 1.f; LAS float* s = scr + kk * 33 + c4; s[0] = g * v[i][0]; s[1] = g * v[i][1]; s[2] = g * v[i][2]; s[3] = g * v[i][3]; }
    asm volatile("s_waitcnt lgkmcnt(0)" ::: "memory");
    const int c = lane & 7;
#pragma unroll
    for (int j = 0; j < 4; ++j) { const int n = (lane >> 3) + 8 * j; const LAS float* s = scr + (8 * c) * 33 + n;
        v4u o; o.x = pk2(s[0 * 33], s[1 * 33]); o.y = pk2(s[2 * 33], s[3 * 33]); o.z = pk2(s[4 * 33], s[5 * 33]); o.w = pk2(s[6 * 33], s[7 * 33]);
        *(v4u*)(dst + (size_t)(rowbase + n) * ldd + k0 + 8 * c) = o; }
    asm volatile("s_waitcnt lgkmcnt(0)" ::: "memory");
}
__device__ __forceinline__ int rmap(int kind, int n) {
    if (kind == 1) return 256 * (n >> 7) + (n & 127);
    if (kind == 2) return 256 * (n >> 7) + 128 + (n & 127);
    if (kind == 3) return n < 768 ? n : (n < 2560 ? n + 256 : n - 2560 + 768);
    if (kind == 4 && n < 768) return 256 * (n >> 8) + 32 * ((n >> 6) & 3) + 128 * ((n >> 5) & 1);
    return n;
}
__device__ __forceinline__ void conv_matrix(const Frame& F, const float* W, int K, int N, const float* gain, bf16_t* dst, int ldd, int kind) {
    LAS float* scr = (LAS float*)(F.lds + RING_OFF + F.wave * 16384);
    const int gw = F.vcu * NWAVES + F.wave, NGW = F.G * NWAVES;
    const int nblk = N / 32, items = (K / 64) * nblk;
    for (int it = gw; it < items; it += NGW) { const int kb = it / nblk, nb = it % nblk; conv_item(W, N, gain, dst, ldd, rmap(kind, 32 * nb), scr, 64 * kb, 32 * nb, F.lane); }
}
__device__ __forceinline__ void conv_ffn(const Frame& F, const float* norm, const float* w1, const float* w3, const float* w2, unsigned char* slot, int part = 0) {
    bf16_t* up = (bf16_t*)slot; bf16_t* dn = (bf16_t*)(slot + SZ_FFN_UP);
    if (part != 2) { conv_matrix(F, w1, 1024, FF, norm, up, 1024, 1); conv_matrix(F, w3, 1024, FF, norm, up, 1024, 2); }
    if (part != 1) conv_matrix(F, w2, FF, 1024, nullptr, dn, FFP, 0);
    if (part == 2) return;
    const int gt = (F.vcu * NWAVES + F.wave) * 64 + F.lane, NT = F.G * NWAVES * 64;
    for (int i = gt; i < 16384; i += NT) { const int r = i >> 7, c = i & 127; const int row = 21 * 256 + (r < 64 ? 64 + r : 192 + (r - 64)); *(v4u*)(up + (size_t)row * 1024 + c * 8) = (v4u){0u, 0u, 0u, 0u}; }
    for (int i = gt; i < 8192; i += NT) { const int r = i >> 3, c = i & 7; *(v4u*)(dn + (size_t)r * FFP + FF + c * 8) = (v4u){0u, 0u, 0u, 0u}; }
}
__device__ __forceinline__ void x_to_xb(const Frame& F, const float* x, bf16_t* xb, float* ssq, int rows, bool rstd_mode) {
    const int gw = F.vcu * NWAVES + F.wave, NGW = F.G * NWAVES;
    for (int m = 2 * gw; m < rows; m += 2 * NGW) {
        const f32x4* xr = (const f32x4*)(x + (size_t)m * D) + F.lane; float s0 = 0.f, s1 = 0.f;
        unsigned long long* o8 = (unsigned long long*)(xb + (size_t)m * D) + F.lane;
        f32x4 v[8];
#pragma unroll
        for (int j = 0; j < 4; ++j) { v[j] = __builtin_nontemporal_load(xr + 64 * j); v[4 + j] = __builtin_nontemporal_load(xr + 256 + 64 * j); }
#pragma unroll
        for (int j = 0; j < 4; ++j) {
            s0 += (v[j][0] * v[j][0] + v[j][1] * v[j][1]) + (v[j][2] * v[j][2] + v[j][3] * v[j][3]);
            s1 += (v[4 + j][0] * v[4 + j][0] + v[4 + j][1] * v[4 + j][1]) + (v[4 + j][2] * v[4 + j][2] + v[4 + j][3] * v[4 + j][3]);
            o8[64 * j] = (unsigned long long)pk2(v[j][0], v[j][1]) | ((unsigned long long)pk2(v[j][2], v[j][3]) << 32);
            o8[256 + 64 * j] = (unsigned long long)pk2(v[4 + j][0], v[4 + j][1]) | ((unsigned long long)pk2(v[4 + j][2], v[4 + j][3]) << 32); }
        s0 = wave_sum(s0); s1 = wave_sum(s1);
        if (rstd_mode) { if (F.lane == 0) { ssq[m] = rsqrtf(s0 * (1.f / 1024.f) + 1e-6f); ssq[m + 1] = rsqrtf(s1 * (1.f / 1024.f) + 1e-6f); } }
        else if (F.lane < 32) ssq[(size_t)m * 16 + F.lane] = F.lane == 0 ? s0 : (F.lane == 16 ? s1 : 0.f);
    }
}
__device__ __forceinline__ void k_post(const Frame& F, bf16_t* KV, const float* kgain, float* kmean) {
    LAS float* sred = (LAS float*)(F.lds + RING_OFF);
    for (int u = blockIdx.x; u < 256; u += F.G) {
        const int b = u >> 2, hg = u & 3;
        float accm[3] = {0.f, 0.f, 0.f};
        const float g = kgain[F.lane];
        for (int r0 = F.wave * 8; r0 < 256; r0 += NWAVES * 8) {
            bf16_t* rowp = KV + (size_t)(b * 256 + r0) * 1536 + hg * 192 + F.lane;
            float v[8][3], ss[8][3];
#pragma unroll
            for (int j = 0; j < 8; ++j)
#pragma unroll
                for (int h = 0; h < 3; ++h) { v[j][h] = bf2f(rowp[(size_t)j * 1536 + h * 64]); ss[j][h] = v[j][h] * v[j][h]; }
#pragma unroll
            for (int o = 1; o < 64; o <<= 1)
#pragma unroll
                for (int j = 0; j < 8; ++j)
#pragma unroll
                    for (int h = 0; h < 3; ++h) ss[j][h] += __shfl_xor(ss[j][h], o);
#pragma unroll
            for (int j = 0; j < 8; ++j)
#pragma unroll
                for (int h = 0; h < 3; ++h) { const float o = v[j][h] * rsqrtf(ss[j][h] * (1.f / 64.f) + 1e-6f) * g; rowp[(size_t)j * 1536 + h * 64] = f2bf_d(o); accm[h] += o; }
        }
#pragma unroll
        for (int h = 0; h < 3; ++h) sred[(F.wave * 3 + h) * 64 + F.lane] = accm[h];
        __syncthreads();
        if (F.tid < 192) { float s = 0.f;
#pragma unroll
            for (int w = 0; w < 8; ++w) s += sred[w * 192 + F.tid];
            kmean[((size_t)(hg * 3 + (F.tid >> 6)) * 64 + b) * 64 + (F.tid & 63)] = s * (1.f / 256.f); }
        __syncthreads();
    }
}
constexpr int RW_MP = 144, RW_MSZ = 64 * RW_MP;
constexpr int L_TW = 0, L_AD = RW_MSZ, L_VT = 2 * RW_MSZ, L_KA = 3 * RW_MSZ, L_BT = 4 * RW_MSZ, L_KT = 5 * RW_MSZ, L_RT = 6 * RW_MSZ, L_BH = 7 * RW_MSZ, L_KH = 8 * RW_MSZ,
              L_AAB = 9 * RW_MSZ, L_AAK = 10 * RW_MSZ, L_G3 = 11 * RW_MSZ, L_G4 = 12 * RW_MSZ, L_DP = 13 * RW_MSZ, L_G63 = L_DP + 3072, L_CS = L_G63 + 256, L_NP = L_CS + 512, L_BP = L_NP + 1024, L_RW_END = L_BP + 1024;
constexpr int L_MUV = L_RW_END, L_MURK = RTAB_OFF;
static_assert(L_MUV + 3072 <= RING_BYTES && RING_OFF == 0, "rwkv LDS");
typedef unsigned u32x2 __attribute__((ext_vector_type(2)));
__device__ __forceinline__ u32x2 pack4(f32x4 v) { u32x2 r; r.x = cvtpk(v[0], v[1]); r.y = cvtpk(v[2], v[3]); return r; }
__device__ __forceinline__ f32x4 unpack4(u32x2 r) { f32x4 v; v[0] = __uint_as_float(r.x << 16); v[1] = __uint_as_float(r.x & 0xffff0000u); v[2] = __uint_as_float(r.y << 16); v[3] = __uint_as_float(r.y & 0xffff0000u); return v; }
__device__ __forceinline__ bf16x8 frag2(u32x2 lo, u32x2 hi) { v4u t; t.x = lo.x; t.y = lo.y; t.z = hi.x; t.w = hi.y; return __builtin_bit_cast(bf16x8, t); }
__device__ __forceinline__ bf16x8 lds16(const LAS unsigned char* p) { return *(const LAS bf16x8*)p; }
__device__ __forceinline__ u32x2 lds8(const LAS unsigned char* p) { return *(const LAS u32x2*)p; }
__device__ __forceinline__ float ldsbf(const LAS unsigned char* p) { return bf2f(*(const LAS bf16_t*)p); }
__device__ __forceinline__ void unpack8(v4u raw, float (&f)[8]) {
    f[0] = __uint_as_float(raw.x << 16); f[1] = __uint_as_float(raw.x & 0xffff0000u); f[2] = __uint_as_float(raw.y << 16); f[3] = __uint_as_float(raw.y & 0xffff0000u);
    f[4] = __uint_as_float(raw.z << 16); f[5] = __uint_as_float(raw.z & 0xffff0000u); f[6] = __uint_as_float(raw.w << 16); f[7] = __uint_as_float(raw.w & 0xffff0000u);
}
#define MFMA16(a, b, c) __builtin_amdgcn_mfma_f32_16x16x32_bf16((a), (b), (c), 0, 0, 0)
__device__ __forceinline__ float dpp_ror(float v, int) { return v; }
#define DPP_ROR_ADD(v, n) ((v) + __int_as_float(__builtin_amdgcn_update_dpp(0, __float_as_int(v), 0x120 + (n), 0xf, 0xf, false)))
__device__ __forceinline__ float grp16_sum(float v) { v = DPP_ROR_ADD(v, 8); v = DPP_ROR_ADD(v, 4); v = DPP_ROR_ADD(v, 2); v = DPP_ROR_ADD(v, 1); return v; }

struct RwkvW { const float *mu, *w0, *a0, *k_k, *k_a, *r_k, *ln_w, *ln_b; const bf16_t *W2T, *A2T, *G2T; };
struct RwkvBuf { unsigned char *MC, *NC, *PF, *Y0; float* SB; };

constexpr int L_RS = L_AAB, L_KS = L_AAB + 17408;
__device__ __forceinline__ float fast_sigmoid(float x) { return __builtin_amdgcn_rcpf(1.f + __expf(-x)); }
__device__ __forceinline__ float fast_tanh(float x) { return 1.f - 2.f * __builtin_amdgcn_rcpf(1.f + __expf(2.f * x)); }
struct S1Head { v4u cr, pr, ck, pk, cv, pv; bf16x8 bw0, bw1, ba0, ba1; float w0c, a0c, kkc, kac, rkc; };
__device__ __forceinline__ void s1_load_raw(S1Head& H, const bf16_t* proj, int t0, int h, int tid) {
    const int i = tid >> 3, j0 = (tid & 7) * 8, t = t0 + i;
    const bf16_t* rowc = proj + (size_t)t * 2816 + h * 64 + j0;
    H.cr = *(const v4u*)(rowc); H.ck = *(const v4u*)(rowc + 1024); H.cv = *(const v4u*)(rowc + 1792);
    H.pr = (v4u){0u, 0u, 0u, 0u}; H.pk = H.pr; H.pv = H.pr;
    if (t > 0) { H.pr = *(const v4u*)(rowc - 2816); H.pk = *(const v4u*)(rowc - 2816 + 1024); H.pv = *(const v4u*)(rowc - 2816 + 1792); }
}
__device__ __forceinline__ void s1_load_frags(S1Head& H, const RwkvW& W, int h, int kt, int lo, int hi) {
    const int ch = h * 64 + 16 * kt + lo;
    H.bw0 = *(const bf16x8*)(W.W2T + (size_t)ch * 64 + 8 * hi); H.bw1 = *(const bf16x8*)(W.W2T + (size_t)ch * 64 + 8 * hi + 32);
    H.ba0 = *(const bf16x8*)(W.A2T + (size_t)ch * 64 + 8 * hi); H.ba1 = *(const bf16x8*)(W.A2T + (size_t)ch * 64 + 8 * hi + 32);
    H.w0c = W.w0[ch]; H.a0c = W.a0[ch]; H.rkc = W.r_k[ch];
}
__device__ __forceinline__ void s1_load_k(S1Head& H, const RwkvW& W, int h, int kt, int lo) { const int ch = h * 64 + 16 * kt + lo; H.kkc = W.k_k[ch]; H.kac = W.k_a[ch]; }
__device__ __forceinline__ void s1_write_head(const S1Head& H, LAS unsigned char* lds, const RwkvW& W, int h, int tid) {
    const int i = tid >> 3, j0 = (tid & 7) * 8, ch0 = h * 64 + j0;
    float cf[8], pf[8];
    unpack8(H.cr, cf); unpack8(H.pr, pf);
    const LAS float* murk = (const LAS float*)(lds + L_MURK); const LAS float* muv = (const LAS float*)(lds + L_MUV);
    { const f32x4 m0 = *(const LAS f32x4*)(murk + ch0), m1 = *(const LAS f32x4*)(murk + ch0 + 4);
      f32x4 o0 = {cf[0] + (pf[0] - cf[0]) * m0[0], cf[1] + (pf[1] - cf[1]) * m0[1], cf[2] + (pf[2] - cf[2]) * m0[2], cf[3] + (pf[3] - cf[3]) * m0[3]};
      f32x4 o1 = {cf[4] + (pf[4] - cf[4]) * m1[0], cf[5] + (pf[5] - cf[5]) * m1[1], cf[6] + (pf[6] - cf[6]) * m1[2], cf[7] + (pf[7] - cf[7]) * m1[3]};
      *(LAS f32x4*)(lds + L_RS + (i * 68 + j0) * 4) = o0; *(LAS f32x4*)(lds + L_RS + (i * 68 + j0 + 4) * 4) = o1; }
    unpack8(H.ck, cf); unpack8(H.pk, pf);
    { const f32x4 m0 = *(const LAS f32x4*)(murk + 768 + ch0), m1 = *(const LAS f32x4*)(murk + 768 + ch0 + 4);
      f32x4 o0 = {cf[0] + (pf[0] - cf[0]) * m0[0], cf[1] + (pf[1] - cf[1]) * m0[1], cf[2] + (pf[2] - cf[2]) * m0[2], cf[3] + (pf[3] - cf[3]) * m0[3]};
      f32x4 o1 = {cf[4] + (pf[4] - cf[4]) * m1[0], cf[5] + (pf[5] - cf[5]) * m1[1], cf[6] + (pf[6] - cf[6]) * m1[2], cf[7] + (pf[7] - cf[7]) * m1[3]};
      *(LAS f32x4*)(lds + L_KS + (i * 68 + j0) * 4) = o0; *(LAS f32x4*)(lds + L_KS + (i * 68 + j0 + 4) * 4) = o1; }
    unpack8(H.cv, cf); unpack8(H.pv, pf);
#pragma unroll
    for (int e = 0; e < 8; ++e) { const float vs = cf[e] + (pf[e] - cf[e]) * muv[ch0 + e]; *(LAS bf16_t*)(lds + L_VT + (j0 + e) * RW_MP + i * 2) = f2bf_d(vs); }
}
__device__ __forceinline__ void rwkv_s1(const Frame& F, const bf16_t* proj, const RwkvW& W, const RwkvBuf& B) {
    LAS unsigned char* lds = F.lds + RING_OFF;
    const int tid = F.tid, lane = F.lane, w = F.wave, lo = lane & 15, hi = lane >> 4;
    const u32x2 z2 = {0u, 0u};
    const int kt = w & 3, ih = w >> 2, k = 16 * kt + lo;
    for (int i = tid; i < 2304; i += NWAVES * 64) { if (i < 1536) ((LAS float*)(lds + L_MURK))[i] = W.mu[i]; else ((LAS float*)(lds + L_MUV))[i - 1536] = W.mu[i]; }
    __syncthreads();
    for (int c = blockIdx.x; c < 256; c += F.G) {
        const int t0 = c * 64;
        {
            const int i = tid >> 3, j0 = (tid & 7) * 8, t = t0 + i;
            const bf16_t* rowc = proj + (size_t)t * 2816; const bool hasp = t > 0;
            v4u cw = *(const v4u*)(rowc + 2560 + j0), ca = *(const v4u*)(rowc + 2624 + j0);
            v4u pw = {0u, 0u, 0u, 0u}, pa = pw;
            if (hasp) { pw = *(const v4u*)(rowc - 2816 + 2560 + j0); pa = *(const v4u*)(rowc - 2816 + 2624 + j0); }
            float cf[8], pf[8], o[8];
            unpack8(cw, cf); unpack8(pw, pf);
#pragma unroll
            for (int e = 0; e < 8; ++e) o[e] = fast_tanh(cf[e] + (pf[e] - cf[e]) * W.mu[2304 + j0 + e]);
            { v4u r; r.x = cvtpk(o[0], o[1]); r.y = cvtpk(o[2], o[3]); r.z = cvtpk(o[4], o[5]); r.w = cvtpk(o[6], o[7]); *(LAS v4u*)(lds + L_TW + i * RW_MP + j0 * 2) = r; }
            unpack8(ca, cf); unpack8(pa, pf);
#pragma unroll
            for (int e = 0; e < 8; ++e) o[e] = cf[e] + (pf[e] - cf[e]) * W.mu[2368 + j0 + e];
            { v4u r; r.x = cvtpk(o[0], o[1]); r.y = cvtpk(o[2], o[3]); r.z = cvtpk(o[4], o[5]); r.w = cvtpk(o[6], o[7]); *(LAS v4u*)(lds + L_AD + i * RW_MP + j0 * 2) = r; }
        }
        S1Head Hc;
        s1_load_raw(Hc, proj, t0, 0, tid); s1_load_frags(Hc, W, 0, kt, lo, hi); s1_load_k(Hc, W, 0, kt, lo);
        s1_write_head(Hc, lds, W, 0, tid);
        __syncthreads();
        for (int h = 0; h < 12; ++h) {
            const int item = c * 12 + h;
            const int hn = h + 1 < 12 ? h + 1 : 11;
            float lw[2][4], av[2][4], kr[2][4], rr[2][4], L[2][4];
#pragma unroll
            for (int itl = 0; itl < 2; ++itl) {
                const int it = 2 * ih + itl;
                const LAS unsigned char* ap = lds + (16 * it + lo) * RW_MP + 16 * hi;
                f32x4 dw = {0.f, 0.f, 0.f, 0.f}, da = dw;
                dw = MFMA16(lds16(ap + L_TW), Hc.bw0, dw); dw = MFMA16(lds16(ap + L_TW + 64), Hc.bw1, dw);
                da = MFMA16(lds16(ap + L_AD), Hc.ba0, da); da = MFMA16(lds16(ap + L_AD + 64), Hc.ba1, da);
#pragma unroll
                for (int r = 0; r < 4; ++r) {
                    const int i = 16 * it + 4 * hi + r;
                    rr[itl][r] = *(const LAS float*)(lds + L_RS + (i * 68 + k) * 4); kr[itl][r] = *(const LAS float*)(lds + L_KS + (i * 68 + k) * 4);
                    const float zz = -(Hc.w0c + dw[r]);
                    const float sp = fmaxf(zz, 0.f) + __logf(1.f + __expf(-fabsf(zz)));
                    lw[itl][r] = -__expf(-sp - 0.5f);
                    av[itl][r] = fast_sigmoid(Hc.a0c + da[r]);
                }
            }
            {
                float ttile0 = 0.f;
#pragma unroll
                for (int itl = 0; itl < 2; ++itl) {
                    float p0 = lw[itl][0], p1 = p0 + lw[itl][1], p2 = p1 + lw[itl][2], p3 = p2 + lw[itl][3];
                    const float s0 = __shfl(p3, lo), s1 = __shfl(p3, lo + 16), s2 = __shfl(p3, lo + 32), s3 = __shfl(p3, lo + 48);
                    const float ex = (hi > 0 ? s0 : 0.f) + (hi > 1 ? s1 : 0.f) + (hi > 2 ? s2 : 0.f) + (itl ? ttile0 : 0.f);
                    L[itl][0] = ex + p0; L[itl][1] = ex + p1; L[itl][2] = ex + p2; L[itl][3] = ex + p3;
                    if (itl == 0) ttile0 = (s0 + s1) + (s2 + s3); else if (hi == 0) *(LAS float*)(lds + L_CS + (ih * 64 + k) * 4) = ttile0 + ((s0 + s1) + (s2 + s3));
#pragma unroll
                    for (int r = 0; r < 4; ++r) {
                        const float kkv = kr[itl][r] * Hc.kkc, kmod = kr[itl][r] * (1.f + (av[itl][r] - 1.f) * Hc.kac);
                        const float q = grp16_sum(kkv * kkv), bq = grp16_sum(rr[itl][r] * kmod * Hc.rkc);
                        if (lo == 0) { const int i = 16 * (2 * ih + itl) + 4 * hi + r; *(LAS float*)(lds + L_NP + (i * 4 + kt) * 4) = q; *(LAS float*)(lds + L_BP + (i * 4 + kt) * 4) = bq; }
                    }
                }
            }
            s1_load_frags(Hc, W, hn, kt, lo, hi);
            __syncthreads();
            {
                const float cs0 = *(const LAS float*)(lds + L_CS + k * 4), cs1 = *(const LAS float*)(lds + L_CS + (64 + k) * 4);
                const float base = ih ? cs0 : 0.f, L63 = cs0 + cs1;
                const float g63v = __expf(L63);
                if (ih == 0 && hi == 0) *(LAS float*)(lds + L_G63 + k * 4) = g63v;
                if (tid < 64) { const f32x4 bp = *(const LAS f32x4*)(lds + L_BP + tid * 16); B.SB[(size_t)(t0 + tid) * 12 + h] = (bp[0] + bp[1]) + (bp[2] + bp[3]); }
#pragma unroll
                for (int itl = 0; itl < 2; ++itl) {
                    const int it = 2 * ih + itl;
                    f32x4 bh, kh;
#pragma unroll
                    for (int r = 0; r < 4; ++r) {
                        const int i = 16 * it + 4 * hi + r;
                        const f32x4 np = *(const LAS f32x4*)(lds + L_NP + i * 16);
                        const float ninv = __builtin_amdgcn_rcpf(fmaxf(__builtin_amdgcn_sqrtf((np[0] + np[1]) + (np[2] + np[3])), 1e-12f));
                        const float Li = L[itl][r] + base, Lp = Li - lw[itl][r];
                        const float a = av[itl][r], kraw = kr[itl][r];
                        const float kap = kraw * Hc.kkc * ninv, b = kap * a, kmod = kraw * (1.f + (a - 1.f) * Hc.kac);
                        const float eL = __expf(Li), emL = __builtin_amdgcn_rcpf(eL), eLp = __expf(Lp), eE = g63v * emL;
                        const int off = i * RW_MP + k * 2;
                        *(LAS bf16_t*)(lds + L_KA + off) = f2bf_d(kap * eLp);
                        *(LAS bf16_t*)(lds + L_BT + off) = f2bf_d(b * emL);
                        *(LAS bf16_t*)(lds + L_KT + off) = f2bf_d(kmod * emL);
                        *(LAS bf16_t*)(lds + L_RT + off) = f2bf_d(rr[itl][r] * eL);
                        bh[r] = b * eE; kh[r] = kmod * eE;
                    }
                    *(LAS u32x2*)(lds + L_BH + k * RW_MP + (16 * it + 4 * hi) * 2) = pack4(bh);
                    *(LAS u32x2*)(lds + L_KH + k * RW_MP + (16 * it + 4 * hi) * 2) = pack4(kh);
                }
            }
            s1_load_raw(Hc, proj, t0, hn, tid); s1_load_k(Hc, W, hn, kt, lo);
            __syncthreads();
            {
                const int mat = w >> 1, hf = w & 1;
                const int offA = (mat & 1) ? L_KT : L_BT, offB = (mat & 2) ? L_RT : L_KA, dst = L_AAB + mat * RW_MSZ;
    #pragma unroll
                for (int e = 0; e < 2; ++e) {
                    const int it = hf ? (1 + e) : (3 * e);
                    const LAS unsigned char* bp = lds + offB + (16 * it + lo) * RW_MP + 16 * hi;
                    const bf16x8 b0 = lds16(bp), b1 = lds16(bp + 64);
                    for (int st = 0; st < 4; ++st) {
                        f32x4 acc = {0.f, 0.f, 0.f, 0.f};
                        if (st <= it) {
                            const LAS unsigned char* ap = lds + offA + (16 * st + lo) * RW_MP + 16 * hi;
                            acc = MFMA16(lds16(ap), b0, acc); acc = MFMA16(lds16(ap + 64), b1, acc);
                            const int i = 16 * it + lo, s0 = 16 * st + 4 * hi;
    #pragma unroll
                            for (int r = 0; r < 4; ++r) { const bool keep = (mat < 2) ? (s0 + r < i) : (s0 + r <= i); acc[r] = keep ? acc[r] : 0.f; }
                        }
                        *(LAS u32x2*)(lds + dst + (16 * it + lo) * RW_MP + (16 * st + 4 * hi) * 2) = pack4(acc);
                    }
                }
            }
            __syncthreads();
            f32x4 xacc[4];
    #pragma unroll
            for (int p = 0; p < 4; ++p) xacc[p] = (f32x4){0.f, 0.f, 0.f, 0.f};
            if (w == 0) {
                float Dc[16];
                int lo_o = lo; asm volatile("" : "+v"(lo_o));
    #pragma unroll
                for (int m = 0; m < 16; ++m) {
                    float acc = (m == lo_o) ? 1.f : 0.f;
    #pragma unroll
                    for (int s = 0; s < m; ++s) acc -= ldsbf(lds + L_AAB + (16 * hi + m) * RW_MP + (16 * hi + s) * 2) * Dc[s];
                    Dc[m] = acc;
                    *(LAS bf16_t*)(lds + L_DP + (16 * hi + m) * 48 + lo * 2) = f2bf_d(acc);
                }
            } else if (w >= 4) {
                const int vt = w - 4;
                const LAS unsigned char* bp = lds + L_VT + (16 * vt + lo) * RW_MP + 16 * hi;
                const bf16x8 b0 = lds16(bp), b1 = lds16(bp + 64);
    #pragma unroll
                for (int it = 0; it < 4; ++it) { const LAS unsigned char* ap = lds + L_AAK + (16 * it + lo) * RW_MP + 16 * hi; xacc[it] = MFMA16(lds16(ap), b0, xacc[it]); xacc[it] = MFMA16(lds16(ap + 64), b1, xacc[it]); }
            }
            __syncthreads();
            const int ct = w & 3; const bool isU = w >= 4;
            u32x2 xp[4];
    #pragma unroll
            for (int p = 0; p < 4; ++p) {
                f32x4 Z;
                if (!isU) {
    #pragma unroll
                    for (int r = 0; r < 4; ++r) Z[r] = ldsbf(lds + L_KA + (16 * p + 4 * hi + r) * RW_MP + (16 * ct + lo) * 2);
                } else Z = -xacc[p];
                if (p >= 1) {
                    f32x4 S = {0.f, 0.f, 0.f, 0.f};
                    const LAS unsigned char* ar = lds + L_AAB + (16 * p + lo) * RW_MP + (4 * hi) * 2;
                    S = MFMA16(frag2(lds8(ar), p >= 2 ? lds8(ar + 32) : z2), frag2(xp[0], p >= 2 ? xp[1] : z2), S);
                    if (p == 3) S = MFMA16(frag2(lds8(ar + 64), z2), frag2(xp[2], z2), S);
                    Z = Z - S;
                }
                const f32x4 X = MFMA16(frag2(lds8(lds + L_DP + (16 * p + lo) * 48 + (4 * hi) * 2), z2), frag2(pack4(Z), z2), ((f32x4){0.f, 0.f, 0.f, 0.f}));
                xp[p] = pack4(X);
            }
            unsigned char* gM = B.MC + (size_t)item * 8192; unsigned char* gN = B.NC + (size_t)item * 8192; unsigned char* gP = B.PF + (size_t)item * 8192; unsigned char* gY = B.Y0 + (size_t)item * 8192;
            const bf16x8 x01 = frag2(xp[0], xp[1]), x23 = frag2(xp[2], xp[3]);
            if (!isU) {
                const int kt2 = ct;
    #pragma unroll
                for (int mt = 0; mt < 4; ++mt) {
                    const LAS unsigned char* bp = lds + L_BH + (16 * mt + lo) * RW_MP + (4 * hi) * 2;
                    f32x4 acc = {0.f, 0.f, 0.f, 0.f};
                    acc = MFMA16(x01, frag2(lds8(bp), lds8(bp + 32)), acc); acc = MFMA16(x23, frag2(lds8(bp + 64), lds8(bp + 96)), acc);
                    const float g63 = *(const LAS float*)(lds + L_G63 + (16 * mt + lo) * 4);
                    f32x4 mv;
    #pragma unroll
                    for (int r = 0; r < 4; ++r) mv[r] = ((16 * kt2 + 4 * hi + r) == (16 * mt + lo) ? g63 : 0.f) - acc[r];
                    *(u32x2*)(gM + (mt * 2 + (kt2 >> 1)) * 1024 + lane * 16 + (kt2 & 1) * 8) = pack4(mv);
                }
    #pragma unroll
                for (int it = 0; it < 4; ++it) {
                    const LAS unsigned char* bp = lds + L_G3 + (16 * it + lo) * RW_MP + (4 * hi) * 2;
                    f32x4 acc = {0.f, 0.f, 0.f, 0.f};
                    acc = MFMA16(x01, frag2(lds8(bp), lds8(bp + 32)), acc); acc = MFMA16(x23, frag2(lds8(bp + 64), lds8(bp + 96)), acc);
                    const f32x4 rt = unpack4(lds8(lds + L_RT + (16 * it + lo) * RW_MP + (16 * kt2 + 4 * hi) * 2));
                    *(u32x2*)(gP + (it * 2 + (kt2 >> 1)) * 1024 + lane * 16 + (kt2 & 1) * 8) = pack4(rt - acc);
                }
            } else {
                const int vt = ct;
                const LAS unsigned char* vp = lds + L_VT + (16 * vt + lo) * RW_MP + 16 * hi;
                const bf16x8 v0 = lds16(vp), v1 = lds16(vp + 64);
    #pragma unroll
                for (int mt = 0; mt < 4; ++mt) {
                    const LAS unsigned char* ap = lds + L_BH + (16 * mt + lo) * RW_MP + (4 * hi) * 2;
                    const LAS unsigned char* kp = lds + L_KH + (16 * mt + lo) * RW_MP + 16 * hi;
                    f32x4 acc = {0.f, 0.f, 0.f, 0.f};
                    acc = MFMA16(frag2(lds8(ap), lds8(ap + 32)), x01, acc); acc = MFMA16(frag2(lds8(ap + 64), lds8(ap + 96)), x23, acc);
                    acc = MFMA16(lds16(kp), v0, acc); acc = MFMA16(lds16(kp + 64), v1, acc);
                    *(u32x2*)(gN + (vt * 4 + mt) * 512 + lane * 8) = pack4(acc);
                }
    #pragma unroll
                for (int it = 0; it < 4; ++it) {
                    const LAS unsigned char* ap = lds + L_G3 + (16 * it + lo) * RW_MP + (4 * hi) * 2;
                    const LAS unsigned char* kp = lds + L_G4 + (16 * it + lo) * RW_MP + 16 * hi;
                    f32x4 acc = {0.f, 0.f, 0.f, 0.f};
                    acc = MFMA16(x01, frag2(lds8(ap), lds8(ap + 32)), acc); acc = MFMA16(x23, frag2(lds8(ap + 64), lds8(ap + 96)), acc);
                    acc = MFMA16(v0, lds16(kp), acc); acc = MFMA16(v1, lds16(kp + 64), acc);
                    *(u32x2*)(gY + (vt * 4 + it) * 512 + lane * 8) = pack4(acc);
                }
            }

            __syncthreads();
            if (h + 1 < 12) s1_write_head(Hc, lds, W, h + 1, tid);
            __syncthreads();
        }
    }
}

constexpr int S2_SLOT = 10240;
#define S2_WAITV(n) asm volatile("s_waitcnt vmcnt(" #n ")" ::: "memory")
#define S2L_LOAD(R, cc) do { const unsigned char* g_ = lbase + (size_t)((cc) < 256 ? (cc) : 255) * cstride; R[0] = *(const v4u*)(g_); R[1] = *(const v4u*)(g_ + 1024); } while (0)
#define S2L_STEP(R, k) do { S2_WAITV(46); \
    LAS unsigned char* sl_ = lds + ((k) & 7) * S2_SLOT + (2 * lw) * 1024 + lane * 16; \
    *(LAS v4u*)(sl_) = R[0]; *(LAS v4u*)(sl_ + 1024) = R[1]; \
    S2L_LOAD(R, (k) + 24); } while (0)
#define S2L_GROUP(Ra_, Rb_, Rc_, Rd_, k) do { S2L_STEP(Ra_, k); S2L_STEP(Rb_, (k) + 1); S2L_STEP(Rc_, (k) + 2); S2L_STEP(Rd_, (k) + 3); \
    asm volatile("s_waitcnt lgkmcnt(0)" ::: "memory"); __builtin_amdgcn_s_barrier(); } while (0)
#define S2M_READ(Mr, Nr, sl) do { const LAS unsigned char* sp_ = lds + (sl) * S2_SLOT + lane * 16; \
    _Pragma("unroll") for (int f = 0; f < 8; ++f) Mr[f] = *(const LAS bf16x8*)(sp_ + f * 1024); \
    const LAS unsigned char* np_ = lds + (sl) * S2_SLOT + 8192 + lane * 8; \
    _Pragma("unroll") for (int mt = 0; mt < 4; ++mt) Nr[mt] = *(const LAS u32x2*)(np_ + mt * 512); } while (0)
#define S2_STEP(Mc, Nc, Mn, Nn, cc, BAR) do { if (BAR) { asm volatile("s_waitcnt lgkmcnt(0)" ::: "memory"); __builtin_amdgcn_s_barrier(); } \
    S2M_READ(Mn, Nn, ((cc) + 1) & 7); \
    f32x4 acc[4]; \
    _Pragma("unroll") for (int mt = 0; mt < 4; ++mt) { acc[mt] = unpack4(Nc[mt]); acc[mt] = MFMA16(Mc[mt * 2], Hf0, acc[mt]); acc[mt] = MFMA16(Mc[mt * 2 + 1], Hf1, acc[mt]); } \
    unsigned char* hp = nb + (size_t)(cc) * cstride + lane * 16; \
    *(bf16x8*)(hp) = Hf0; *(bf16x8*)(hp + 1024) = Hf1;     \
    Hf0 = frag2(pack4(acc[0]), pack4(acc[1])); Hf1 = frag2(pack4(acc[2]), pack4(acc[3])); } while (0)
constexpr int S2_NWG = 64;
__device__ __forceinline__ void rwkv_s2(const Frame& F, const RwkvBuf& B) {
    const int g = blockIdx.x;
    if (g >= S2_NWG) return;
    int h, vs;
    if (g < 32) { h = g & 7; vs = g >> 3; } else { if ((g & 7) >= 4) return; h = 8 + (g & 7); vs = (g - 32) >> 3; }
    LAS unsigned char* lds = F.lds + RING_OFF;
    const int lane = F.lane, w = F.wave;
    const unsigned char* mb = B.MC + (size_t)h * 8192;
    unsigned char* nb = B.NC + (size_t)h * 8192 + vs * 2048;
    const size_t cstride = (size_t)12 * 8192;
    if (w >= 1 && w < 6) {
        const int lw = w - 1;
        const unsigned char* lbase = (lw < 4 ? mb + (2 * lw) * 1024 : (const unsigned char*)nb) + lane * 16;
        v4u R0[2], R1[2], R2[2], R3[2], R4[2], R5[2], R6[2], R7[2], R8[2], R9[2], Ra[2], Rb[2];
        v4u Rc[2], Rd[2], Re[2], Rf[2], Rg[2], Rh[2], Ri[2], Rj[2], Rk[2], Rl[2], Rm[2], Rn[2];
        S2L_LOAD(R0, 0); S2L_LOAD(R1, 1); S2L_LOAD(R2, 2); S2L_LOAD(R3, 3); S2L_LOAD(R4, 4); S2L_LOAD(R5, 5);
        S2L_LOAD(R6, 6); S2L_LOAD(R7, 7); S2L_LOAD(R8, 8); S2L_LOAD(R9, 9); S2L_LOAD(Ra, 10); S2L_LOAD(Rb, 11);
        S2L_LOAD(Rc, 12); S2L_LOAD(Rd, 13); S2L_LOAD(Re, 14); S2L_LOAD(Rf, 15); S2L_LOAD(Rg, 16); S2L_LOAD(Rh, 17);
        S2L_LOAD(Ri, 18); S2L_LOAD(Rj, 19); S2L_LOAD(Rk, 20); S2L_LOAD(Rl, 21); S2L_LOAD(Rm, 22); S2L_LOAD(Rn, 23);
#pragma unroll 1
        for (int k = 0; k < 264; k += 24) {
            S2L_GROUP(R0, R1, R2, R3, k);      S2L_GROUP(R4, R5, R6, R7, k + 4);   S2L_GROUP(R8, R9, Ra, Rb, k + 8);
            S2L_GROUP(Rc, Rd, Re, Rf, k + 12); S2L_GROUP(Rg, Rh, Ri, Rj, k + 16);  S2L_GROUP(Rk, Rl, Rm, Rn, k + 20);
        }
    } else if (w >= 6) {
#pragma unroll 1
        for (int j = 0; j < 66; ++j) __builtin_amdgcn_s_barrier();
    } else {
        bf16x8 Hf0 = {0, 0, 0, 0, 0, 0, 0, 0}, Hf1 = Hf0;
        bf16x8 Ma[8], Mb[8];
        u32x2 Na[4], Nb[4];
        __builtin_amdgcn_s_barrier();
        S2M_READ(Ma, Na, 0);
#pragma unroll 1
        for (int c = 0; c < 256; c += 4) {
            S2_STEP(Ma, Na, Mb, Nb, c, false);
            S2_STEP(Mb, Nb, Ma, Na, c + 1, false);
            S2_STEP(Ma, Na, Mb, Nb, c + 2, false);
            S2_STEP(Mb, Nb, Ma, Na, c + 3, true);
        }
        __builtin_amdgcn_s_barrier();
    }
}

constexpr int L3_SG = 0, L3_SGP = 272, L3_LN = 64 * 272;
constexpr int L3_G = L3_LN + 3 * 768 * 4, L3_GH = 64 * 272, L3_H = L3_G + 2 * L3_GH;
struct S3Priv { bf16x8 P0, P1; u32x2 Yi[4], cv[4], pv[4]; float sb; };
__device__ __forceinline__ void s3_load_priv(S3Priv& Q, const RwkvBuf& B, const bf16_t* rowc, int t, int c, int h, int it, int lane, int hi) {
    const int item = c * 12 + h, ch0 = h * 64 + 16 * hi, lo = lane & 15;
    const unsigned char* gP = B.PF + (size_t)item * 8192; const unsigned char* gY = B.Y0 + (size_t)item * 8192;
    Q.P0 = *(const bf16x8*)(gP + (it * 2 + 0) * 1024 + lane * 16); Q.P1 = *(const bf16x8*)(gP + (it * 2 + 1) * 1024 + lane * 16);
    Q.sb = B.SB[(size_t)t * 12 + h];
#pragma unroll
    for (int v = 0; v < 4; ++v) Q.Yi[v] = *(const u32x2*)(gY + (hi * 4 + it) * 512 + (v * 16 + lo) * 8);
    const v4u ca = *(const v4u*)(rowc + 1792 + ch0), cb = *(const v4u*)(rowc + 1792 + ch0 + 8);
    v4u pa = {0u, 0u, 0u, 0u}, pb = pa;
    if (t > 0) { pa = *(const v4u*)(rowc - 2816 + 1792 + ch0); pb = *(const v4u*)(rowc - 2816 + 1792 + ch0 + 8); }
    Q.cv[0] = (u32x2){ca.x, ca.y}; Q.cv[1] = (u32x2){ca.z, ca.w}; Q.cv[2] = (u32x2){cb.x, cb.y}; Q.cv[3] = (u32x2){cb.z, cb.w};
    Q.pv[0] = (u32x2){pa.x, pa.y}; Q.pv[1] = (u32x2){pa.z, pa.w}; Q.pv[2] = (u32x2){pb.x, pb.y}; Q.pv[3] = (u32x2){pb.z, pb.w};
}
struct S3Stage { v4u g[4], h[2]; };
__device__ __forceinline__ void s3_load_stage(S3Stage& S, const RwkvW& W, const RwkvBuf& B, int c, int hh, int tid) {
#pragma unroll
    for (int q = 0; q < 4; ++q) { const int idx = tid + 512 * q, par = idx >> 10, wi = idx & 1023; S.g[q] = *(const v4u*)(W.G2T + (size_t)((2 * hh + par) * 64 + (wi >> 4)) * 128 + (wi & 15) * 8); }
#pragma unroll
    for (int q = 0; q < 2; ++q) { const int idx = tid + 512 * q, par = idx >> 9, wi = idx & 511; S.h[q] = *(const v4u*)(B.NC + (size_t)(c * 12 + 2 * hh + par) * 8192 + wi * 16); }
}
__device__ __forceinline__ void s3_write_stage(const S3Stage& S, LAS unsigned char* lds, int tid) {
#pragma unroll
    for (int q = 0; q < 4; ++q) { const int idx = tid + 512 * q, par = idx >> 10, wi = idx & 1023; *(LAS v4u*)(lds + L3_G + par * L3_GH + (wi >> 4) * 272 + (wi & 15) * 16) = S.g[q]; }
#pragma unroll
    for (int q = 0; q < 2; ++q) { const int idx = tid + 512 * q, par = idx >> 9, wi = idx & 511; *(LAS v4u*)(lds + L3_H + par * 8192 + wi * 16) = S.h[q]; }
}
__device__ __forceinline__ void rwkv_s3(const Frame& F, bf16_t* proj, const RwkvW& W, const RwkvBuf& B) {
    LAS unsigned char* lds = F.lds + RING_OFF;
    const int tid = F.tid, lane = F.lane, w = F.wave, lo = lane & 15, hi = lane >> 4;
    const int it = w & 3, par = w >> 2;
    LAS float* lnt = (LAS float*)(lds + L3_LN);
    for (int i = tid; i < 768; i += NWAVES * 64) { lnt[i] = W.ln_w[i]; lnt[768 + i] = W.ln_b[i]; lnt[1536 + i] = W.mu[1536 + i]; }
    for (int c = blockIdx.x; c < 256; c += F.G) {
        const int t0 = c * 64;
        const int t = t0 + 16 * it + lo;
        bf16_t* rowc = proj + (size_t)t * 2816;
        S3Stage ST; S3Priv Qc;
        s3_load_stage(ST, W, B, c, 0, tid);
        s3_load_priv(Qc, B, rowc, t, c, par, it, lane, hi);
        {
            const int i = tid >> 3, j0 = (tid & 7) * 16, tt = t0 + i;
            const bf16_t* rowg = proj + (size_t)tt * 2816 + 2688 + j0;
#pragma unroll
            for (int hh = 0; hh < 2; ++hh) {
                const v4u cg = *(const v4u*)(rowg + 8 * hh); v4u pg = {0u, 0u, 0u, 0u};
                if (tt > 0) pg = *(const v4u*)(rowg - 2816 + 8 * hh);
                float cf[8], pf[8], o[8]; unpack8(cg, cf); unpack8(pg, pf);
#pragma unroll
                for (int e = 0; e < 8; ++e) o[e] = fast_sigmoid(cf[e] + (pf[e] - cf[e]) * W.mu[2432 + j0 + 8 * hh + e]);
                v4u r; r.x = cvtpk(o[0], o[1]); r.y = cvtpk(o[2], o[3]); r.z = cvtpk(o[4], o[5]); r.w = cvtpk(o[6], o[7]);
                *(LAS v4u*)(lds + L3_SG + i * L3_SGP + (j0 + 8 * hh) * 2) = r;
            }
        }
        s3_write_stage(ST, lds, tid);
        __syncthreads();
        const LAS unsigned char* sp = lds + L3_SG + (16 * it + lo) * L3_SGP + 16 * hi;
        const bf16x8 sg0 = lds16(sp), sg1 = lds16(sp + 64), sg2 = lds16(sp + 128), sg3 = lds16(sp + 192);
#pragma unroll 1
        for (int hh = 0; hh < 6; ++hh) {
            const int h = 2 * hh + par, ch0 = h * 64 + 16 * hi;
            S3Priv Qn;
            if (hh < 5) { s3_load_stage(ST, W, B, c, hh + 1, tid); s3_load_priv(Qn, B, rowc, t, c, h + 2, it, lane, hi); }
            f32x4 y[4], g[4];
            const LAS unsigned char* gl = lds + L3_G + par * L3_GH + (16 * (lo >> 2) + (lo & 3)) * 272 + 16 * hi;
            const LAS unsigned char* hl = lds + L3_H + par * 8192 + (lo >> 2) * 2048 + (16 * hi + (lo & 3)) * 16;
#pragma unroll
            for (int vt = 0; vt < 4; ++vt) {
                y[vt] = unpack4(Qc.Yi[vt]);
                y[vt] = MFMA16(lds16(hl + (4 * vt) * 16), Qc.P0, y[vt]); y[vt] = MFMA16(lds16(hl + 1024 + (4 * vt) * 16), Qc.P1, y[vt]);
                g[vt] = (f32x4){0.f, 0.f, 0.f, 0.f};
                const LAS unsigned char* gv = gl + (4 * vt) * 272;
                g[vt] = MFMA16(lds16(gv), sg0, g[vt]); g[vt] = MFMA16(lds16(gv + 64), sg1, g[vt]); g[vt] = MFMA16(lds16(gv + 128), sg2, g[vt]); g[vt] = MFMA16(lds16(gv + 192), sg3, g[vt]);
            }
            float s = 0.f;
#pragma unroll
            for (int vt = 0; vt < 4; ++vt) s += (y[vt][0] + y[vt][1]) + (y[vt][2] + y[vt][3]);
            s += __shfl_xor(s, 16); s += __shfl_xor(s, 32);
            const float mean = s * (1.f / 64.f);
            float m2 = 0.f;
#pragma unroll
            for (int vt = 0; vt < 4; ++vt) { const f32x4 d = y[vt] - mean; m2 += (d[0] * d[0] + d[1] * d[1]) + (d[2] * d[2] + d[3] * d[3]); }
            m2 += __shfl_xor(m2, 16); m2 += __shfl_xor(m2, 32);
            const float rstd = rsqrtf(m2 * (1.f / 64.f) + 64e-5f);
            u32x2 ow[4];
#pragma unroll
            for (int vt = 0; vt < 4; ++vt) {
                const int ch = ch0 + 4 * vt;
                const f32x4 lnw = *(const LAS f32x4*)(lnt + ch), lnb = *(const LAS f32x4*)(lnt + 768 + ch), muv = *(const LAS f32x4*)(lnt + 1536 + ch);
                const f32x4 cvf = unpack4(Qc.cv[vt]), pvf = unpack4(Qc.pv[vt]);
                const f32x4 vs = cvf + (pvf - cvf) * muv;
                const f32x4 yn = (y[vt] - mean) * rstd * lnw + lnb;
                ow[vt] = pack4((yn + vs * Qc.sb) * g[vt]);
            }
            *(v4u*)(rowc + ch0) = (v4u){ow[0].x, ow[0].y, ow[1].x, ow[1].y}; *(v4u*)(rowc + ch0 + 8) = (v4u){ow[2].x, ow[2].y, ow[3].x, ow[3].y};
            __syncthreads();
            if (hh < 5) { s3_write_stage(ST, lds, tid); Qc = Qn; }
            __syncthreads();
        }
    }
}
constexpr int AT_KP = 144, AT_VP = 528;
constexpr int L_AK = 0, L_AV = 256 * AT_KP, L_AEND = L_AV + 256 * AT_KP, L_APFX = L_AEND;
static_assert(L_APFX + 8192 <= RING_BYTES, "attn LDS");
constexpr float QSCALE = 0.125f * 1.4426950408889634f;

typedef short v4i16_t __attribute__((ext_vector_type(4)));
__device__ __forceinline__ u32x2 ldstr8(const LAS unsigned char* p) { return __builtin_bit_cast(u32x2, __builtin_amdgcn_ds_read_tr16_b64_v4i16((LAS v4i16_t*)p)); }
__device__ __forceinline__ void attn_store16(bf16_t* p, const f32x4 (&o)[4], float sc) {
    const u32x2 a = pack4(o[0] * sc), b = pack4(o[1] * sc), c = pack4(o[2] * sc), d = pack4(o[3] * sc);
    *(v4u*)(p) = (v4u){a.x, a.y, b.x, b.y}; *(v4u*)(p + 8) = (v4u){c.x, c.y, d.x, d.y};
}
template <bool BIAS, bool CAUSAL>
__device__ __forceinline__ void attn_core(const LAS unsigned char* lds, bf16x8 q0, bf16x8 q1, int npairs, float slope2, float trel, int lo, int hi, f32x4 (&o)[4], float& l) {
#pragma unroll 1
    for (int kp = 0; kp < npairs; ++kp) {
        f32x4 s[2];
#pragma unroll
        for (int e = 0; e < 2; ++e) {
            const int kt = 2 * kp + e;
            const LAS unsigned char* ap = lds + L_AK + (16 * kt + lo) * AT_KP + 16 * hi;
            f32x4 a = {0.f, 0.f, 0.f, 0.f};
            a = MFMA16(lds16(ap), q0, a); a = MFMA16(lds16(ap + 64), q1, a);
            const float kb = (float)(16 * kt + 4 * hi);
#pragma unroll
            for (int r = 0; r < 4; ++r) {
                float x = a[r];
                if (BIAS) { x = x + (slope2 * (kb + (float)r) - slope2 * trel); if (CAUSAL && kb + (float)r > trel) x = -INFINITY; }
                const float p = __builtin_amdgcn_exp2f(x); l += p; a[r] = p;
            }
            s[e] = a;
        }
        const bf16x8 pf = frag2(pack4(s[0]), pack4(s[1]));
#pragma unroll
        for (int dt = 0; dt < 4; ++dt) {
            const LAS unsigned char* vp = lds + L_AV + (32 * kp + 4 * hi + (lo >> 2)) * AT_KP + (16 * (lo & 3) + 4 * dt) * 2;
            o[dt] = MFMA16(frag2(ldstr8(vp), ldstr8(vp + 16 * AT_KP)), pf, o[dt]);
        }
    }
}
struct KvRegs { v4u k[4], v[4]; };
__device__ __forceinline__ void kv_load(KvRegs& R, const bf16_t* Ksrc, const bf16_t* Vsrc, int ld, int tid) {
    const int row = tid >> 1, hf = tid & 1;
    const v4u* kp = (const v4u*)(Ksrc + (size_t)row * ld + hf * 32); const v4u* vp = (const v4u*)(Vsrc + (size_t)row * ld + hf * 32);
#pragma unroll
    for (int j = 0; j < 4; ++j) { R.k[j] = kp[j]; R.v[j] = vp[j]; }
}
__device__ __forceinline__ void kv_write(const KvRegs& R, LAS unsigned char* lds, int tid) {
    const int row = tid >> 1, hf = tid & 1;
#pragma unroll
    for (int j = 0; j < 4; ++j) {
        *(LAS v4u*)(lds + L_AK + row * AT_KP + hf * 64 + j * 16) = R.k[j];
        *(LAS v4u*)(lds + L_AV + row * AT_KP + hf * 64 + j * 16) = R.v[j];
    }
}
__device__ __forceinline__ void stage_kv_bf16(LAS unsigned char* lds, const bf16_t* Ksrc, const bf16_t* Vsrc, int ld, int tid) { KvRegs R; kv_load(R, Ksrc, Vsrc, ld, tid); kv_write(R, lds, tid); }
__device__ __forceinline__ void mem_attn_fast(const Frame& F, bf16_t* proj, int ldq, int qcol0, const float* qgain, const bf16_t* memkv) {
    LAS unsigned char* lds = F.lds + RING_OFF;
    const int lane = F.lane, lo = lane & 15, hi = lane >> 4;
    for (int unit = blockIdx.x; unit < 256; unit += F.G) {
        const int hm = unit & 3, tq = (unit >> 2) * 256;
        stage_kv_bf16(lds, memkv + hm * 64, memkv + 256 + hm * 64, 1024, F.tid);
        __syncthreads();
        const f32x4 ga0 = *(const f32x4*)(qgain + 8 * hi) * QSCALE, ga1 = *(const f32x4*)(qgain + 8 * hi + 4) * QSCALE, gb0 = *(const f32x4*)(qgain + 32 + 8 * hi) * QSCALE, gb1 = *(const f32x4*)(qgain + 32 + 8 * hi + 4) * QSCALE;
#pragma unroll 1
        for (int tt = 0; tt < 2; ++tt) {
            const int t = tq + 32 * F.wave + 16 * tt + lo;
            bf16_t* qp = proj + (size_t)t * ldq + qcol0 + hm * 64;
            const v4u ra = *(const v4u*)(qp + 8 * hi), rb = *(const v4u*)(qp + 32 + 8 * hi);
            f32x4 a0 = {__uint_as_float(ra.x << 16), __uint_as_float(ra.x & 0xffff0000u), __uint_as_float(ra.y << 16), __uint_as_float(ra.y & 0xffff0000u)};
            f32x4 a1 = {__uint_as_float(ra.z << 16), __uint_as_float(ra.z & 0xffff0000u), __uint_as_float(ra.w << 16), __uint_as_float(ra.w & 0xffff0000u)};
            f32x4 b0 = {__uint_as_float(rb.x << 16), __uint_as_float(rb.x & 0xffff0000u), __uint_as_float(rb.y << 16), __uint_as_float(rb.y & 0xffff0000u)};
            f32x4 b1 = {__uint_as_float(rb.z << 16), __uint_as_float(rb.z & 0xffff0000u), __uint_as_float(rb.w << 16), __uint_as_float(rb.w & 0xffff0000u)};
            const f32x4 sq = a0 * a0 + a1 * a1 + b0 * b0 + b1 * b1;
            float ss = (sq[0] + sq[1]) + (sq[2] + sq[3]);
            ss += __shfl_xor(ss, 16); ss += __shfl_xor(ss, 32);
            const float rs = rsqrtf(ss * (1.f / 64.f) + 1e-6f);
            a0 = a0 * ga0 * rs; a1 = a1 * ga1 * rs; b0 = b0 * gb0 * rs; b1 = b1 * gb1 * rs;
            v4u r0, r1;
            r0.x = cvtpk(a0[0], a0[1]); r0.y = cvtpk(a0[2], a0[3]); r0.z = cvtpk(a1[0], a1[1]); r0.w = cvtpk(a1[2], a1[3]);
            r1.x = cvtpk(b0[0], b0[1]); r1.y = cvtpk(b0[2], b0[3]); r1.z = cvtpk(b1[0], b1[1]); r1.w = cvtpk(b1[2], b1[3]);
            f32x4 o[4]; float l = 0.f;
#pragma unroll
            for (int dt = 0; dt < 4; ++dt) o[dt] = (f32x4){0.f, 0.f, 0.f, 0.f};
            attn_core<false, false>(lds, __builtin_bit_cast(bf16x8, r0), __builtin_bit_cast(bf16x8, r1), 8, 0.f, 0.f, lo, hi, o, l);
            l += __shfl_xor(l, 16); l += __shfl_xor(l, 32);
            const float inv = 1.f / l;
            attn_store16(qp + 16 * hi, o, inv);
        }
        __syncthreads();
    }
}
struct MobaBuf { unsigned* cnt; unsigned short* list; unsigned char* nsel; bf16_t* slot0; bf16_t* slot1; bf16_t* slot2; float* lsl; };
__device__ __forceinline__ void top3_insert(float v, int i, float& v0, float& v1, float& v2, int& i0, int& i1, int& i2) {
    const bool b0 = v > v0 || (v == v0 && i < i0), b1 = v > v1 || (v == v1 && i < i1), b2 = v > v2 || (v == v2 && i < i2);
    v2 = b1 ? v1 : (b2 ? v : v2); i2 = b1 ? i1 : (b2 ? i : i2);
    v1 = b0 ? v0 : (b1 ? v : v1); i1 = b0 ? i0 : (b1 ? i : i1);
    v0 = b0 ? v : v0; i0 = b0 ? i : i0;
}
struct RouteSel { int i0, i1, i2; int p0, p1, p2; int t; };
constexpr int L_RKH = 1024, L_RKL = 1024 + 64 * 144;
__device__ __forceinline__ void moba_route(const Frame& F, bf16_t* proj, const float* qgain, const float* kgain, const float* kmean, const MobaBuf& B) {
    LAS unsigned char* lds = F.lds + RING_OFF;
    LAS int* cntL = (LAS int*)lds; LAS int* baseL = cntL + 64;
    const int lane = F.lane, lo = lane & 15, hi = lane >> 4;
    float kbound = fabsf(kgain[lane]), qbound = fabsf(qgain[lane]);
#pragma unroll
    for (int o = 1; o < 64; o <<= 1) { kbound = fmaxf(kbound, __shfl_xor(kbound, o)); qbound = fmaxf(qbound, __shfl_xor(qbound, o)); }
    kbound *= 8.0f * 1.02f * qbound;
    const f32x4 ga0 = *(const f32x4*)(qgain + 8 * hi), ga1 = *(const f32x4*)(qgain + 8 * hi + 4), gb0 = *(const f32x4*)(qgain + 32 + 8 * hi), gb1 = *(const f32x4*)(qgain + 32 + 8 * hi + 4);
    for (int u = blockIdx.x; u < 12 * 64; u += F.G) {
        const int h = u % 12, i_blk = u / 12;
        if (F.tid < 64) cntL[F.tid] = 0;
        {
            const int n = F.tid >> 3, d0 = (F.tid & 7) * 8;
            const float* kp = kmean + ((size_t)h * 64 + n) * 64 + d0;
            const f32x4 k0 = *(const f32x4*)(kp), k1 = *(const f32x4*)(kp + 4);
            v4u kh, kl; kh.x = cvtpk(k0[0], k0[1]); kh.y = cvtpk(k0[2], k0[3]); kh.z = cvtpk(k1[0], k1[1]); kh.w = cvtpk(k1[2], k1[3]);
            const f32x4 e0 = k0 - unpack4((u32x2){kh.x, kh.y}), e1 = k1 - unpack4((u32x2){kh.z, kh.w});
            kl.x = cvtpk(e0[0], e0[1]); kl.y = cvtpk(e0[2], e0[3]); kl.z = cvtpk(e1[0], e1[1]); kl.w = cvtpk(e1[2], e1[3]);
            *(LAS v4u*)(lds + L_RKH + n * 144 + d0 * 2) = kh; *(LAS v4u*)(lds + L_RKL + n * 144 + d0 * 2) = kl;
        }
        __syncthreads();
        const float slope2 = exp2f(-8.0f * (float)(h + 1) / 12.0f) * 1.4426950408889634f;
        const int ntile = (i_blk + 15) >> 4;
        RouteSel R[2];
#pragma unroll
        for (int e = 0; e < 2; ++e) {
            const int t = i_blk * 256 + 32 * F.wave + 16 * e + lo;
            bf16_t* qp = proj + (size_t)t * 1024 + h * 64;
            const v4u ra = *(const v4u*)(qp + 8 * hi), rb = *(const v4u*)(qp + 32 + 8 * hi);
            f32x4 a0 = {__uint_as_float(ra.x << 16), __uint_as_float(ra.x & 0xffff0000u), __uint_as_float(ra.y << 16), __uint_as_float(ra.y & 0xffff0000u)};
            f32x4 a1 = {__uint_as_float(ra.z << 16), __uint_as_float(ra.z & 0xffff0000u), __uint_as_float(ra.w << 16), __uint_as_float(ra.w & 0xffff0000u)};
            f32x4 b0 = {__uint_as_float(rb.x << 16), __uint_as_float(rb.x & 0xffff0000u), __uint_as_float(rb.y << 16), __uint_as_float(rb.y & 0xffff0000u)};
            f32x4 b1 = {__uint_as_float(rb.z << 16), __uint_as_float(rb.z & 0xffff0000u), __uint_as_float(rb.w << 16), __uint_as_float(rb.w & 0xffff0000u)};
            const f32x4 sq = a0 * a0 + a1 * a1 + b0 * b0 + b1 * b1;
            float ss = (sq[0] + sq[1]) + (sq[2] + sq[3]);
            ss += __shfl_xor(ss, 16); ss += __shfl_xor(ss, 32);
            const float rs = rsqrtf(ss * (1.f / 64.f) + 1e-6f) * QSCALE;
            a0 = a0 * ga0 * rs; a1 = a1 * ga1 * rs; b0 = b0 * gb0 * rs; b1 = b1 * gb1 * rs;
            v4u h0, h1, l0, l1;
            h0.x = cvtpk(a0[0], a0[1]); h0.y = cvtpk(a0[2], a0[3]); h0.z = cvtpk(a1[0], a1[1]); h0.w = cvtpk(a1[2], a1[3]);
            h1.x = cvtpk(b0[0], b0[1]); h1.y = cvtpk(b0[2], b0[3]); h1.z = cvtpk(b1[0], b1[1]); h1.w = cvtpk(b1[2], b1[3]);
            {
                const f32x4 d0 = a0 - unpack4((u32x2){h0.x, h0.y}), d1 = a1 - unpack4((u32x2){h0.z, h0.w}), d2 = b0 - unpack4((u32x2){h1.x, h1.y}), d3 = b1 - unpack4((u32x2){h1.z, h1.w});
                l0.x = cvtpk(d0[0], d0[1]); l0.y = cvtpk(d0[2], d0[3]); l0.z = cvtpk(d1[0], d1[1]); l0.w = cvtpk(d1[2], d1[3]);
                l1.x = cvtpk(d2[0], d2[1]); l1.y = cvtpk(d2[2], d2[3]); l1.z = cvtpk(d3[0], d3[1]); l1.w = cvtpk(d3[2], d3[3]);
            }
            const bf16x8 qh0 = __builtin_bit_cast(bf16x8, h0), qh1 = __builtin_bit_cast(bf16x8, h1), ql0 = __builtin_bit_cast(bf16x8, l0), ql1 = __builtin_bit_cast(bf16x8, l1);
            *(v4u*)(qp + 8 * hi) = h0; *(v4u*)(qp + 32 + 8 * hi) = h1;
            float v0 = -INFINITY, v1 = -INFINITY, v2 = -INFINITY; int i0 = 0x7fffffff, i1 = 0x7fffffff, i2 = 0x7fffffff;
#pragma unroll
            for (int nt = 0; nt < 4; ++nt) {
                if (nt < ntile) {
                    f32x4 acc = {0.f, 0.f, 0.f, 0.f};
                    const LAS unsigned char* kr = lds + (16 * nt + lo) * 144 + 16 * hi;
#pragma unroll
                    for (int ks = 0; ks < 2; ++ks) {
                        const bf16x8 kha = lds16(kr + L_RKH + 64 * ks), kla = lds16(kr + L_RKL + 64 * ks);
                        acc = MFMA16(kha, ks ? qh1 : qh0, acc); acc = MFMA16(kha, ks ? ql1 : ql0, acc); acc = MFMA16(kla, ks ? qh1 : qh0, acc);
                    }
#pragma unroll
                    for (int r = 0; r < 4; ++r) { const int n = 16 * nt + 4 * hi + r; if (n < i_blk) top3_insert(acc[r], n, v0, v1, v2, i0, i1, i2); }
                }
            }
#pragma unroll
            for (int o = 16; o <= 32; o <<= 1) {
                const float w0 = __shfl_xor(v0, o), w1 = __shfl_xor(v1, o), w2 = __shfl_xor(v2, o); const int j0 = __shfl_xor(i0, o), j1 = __shfl_xor(i1, o), j2 = __shfl_xor(i2, o);
                top3_insert(w0, j0, v0, v1, v2, i0, i1, i2); top3_insert(w1, j1, v0, v1, v2, i0, i1, i2); top3_insert(w2, j2, v0, v1, v2, i0, i1, i2);
            }
            const float smax = sqrtf(ss * (rs * rs)) * kbound;
            R[e].t = t; R[e].i0 = -1; R[e].i1 = -1; R[e].i2 = -1; R[e].p0 = 0; R[e].p1 = 0; R[e].p2 = 0;
            if (hi == 0) {
                if (v0 > -INFINITY && slope2 * (float)(t - 256 * i0 - 255) - smax <= 150.f) { R[e].i0 = i0; R[e].p0 = __hip_atomic_fetch_add((int*)(cntL + i0), 1, __ATOMIC_RELAXED, __HIP_MEMORY_SCOPE_WORKGROUP); }
                if (v1 > -INFINITY && slope2 * (float)(t - 256 * i1 - 255) - smax <= 150.f) { R[e].i1 = i1; R[e].p1 = __hip_atomic_fetch_add((int*)(cntL + i1), 1, __ATOMIC_RELAXED, __HIP_MEMORY_SCOPE_WORKGROUP); }
                if (v2 > -INFINITY && slope2 * (float)(t - 256 * i2 - 255) - smax <= 150.f) { R[e].i2 = i2; R[e].p2 = __hip_atomic_fetch_add((int*)(cntL + i2), 1, __ATOMIC_RELAXED, __HIP_MEMORY_SCOPE_WORKGROUP); }
            }
        }
        __syncthreads();
        if (F.tid < 64) { const int c = cntL[F.tid]; int b = 0; if (c > 0) b = (int)atomicAdd(B.cnt + h * 64 + F.tid, (unsigned)c); baseL[F.tid] = b; }
        __syncthreads();
        if (hi == 0) {
#pragma unroll
            for (int e = 0; e < 2; ++e) {
                int nl = 0; const int t = R[e].t;
                if (R[e].i0 >= 0) { B.list[(size_t)(h * 64 + R[e].i0) * 16384 + baseL[R[e].i0] + R[e].p0] = (unsigned short)(t | (nl << 14)); ++nl; }
                if (R[e].i1 >= 0) { B.list[(size_t)(h * 64 + R[e].i1) * 16384 + baseL[R[e].i1] + R[e].p1] = (unsigned short)(t | (nl << 14)); ++nl; }
                if (R[e].i2 >= 0) { B.list[(size_t)(h * 64 + R[e].i2) * 16384 + baseL[R[e].i2] + R[e].p2] = (unsigned short)(t | (nl << 14)); ++nl; }
                B.nsel[(size_t)t * 12 + h] = (unsigned char)nl;
            }
        }
        __syncthreads();
    }
}
__device__ __forceinline__ void moba_selected(const Frame& F, const bf16_t* proj, const bf16_t* KV, const MobaBuf& B) {
    LAS unsigned char* lds = F.lds + RING_OFF;
    LAS int* pfx = (LAS int*)(lds + L_APFX); LAS int* cntl = pfx + 772;
    const int lane = F.lane, lo = lane & 15, hi = lane >> 4;
    if (F.wave == 0) {
        int loc[12]; int s = 0;
#pragma unroll
        for (int j = 0; j < 12; ++j) { const int c = (int)__hip_atomic_load(B.cnt + lane * 12 + j, __ATOMIC_RELAXED, __HIP_MEMORY_SCOPE_AGENT); cntl[lane * 12 + j] = c; loc[j] = (c + 511) >> 9; s += loc[j]; }
        int inc = s;
#pragma unroll
        for (int o = 1; o < 64; o <<= 1) { const int v = __shfl_up(inc, o); if (lane >= o) inc += v; }
        int ex = inc - s;
#pragma unroll
        for (int j = 0; j < 12; ++j) { pfx[lane * 12 + j] = ex; ex += loc[j]; }
        if (lane == 63) pfx[768] = inc;
    }
    __syncthreads();
    const int total = pfx[768];
    unsigned* qctr = B.cnt + 768;
    LAS int* qw = cntl + 768;
    if (F.tid == 0) { qw[0] = (int)atomicAdd(qctr, 1u); qw[1] = (int)atomicAdd(qctr, 1u); }
    __syncthreads();
    KvRegs KR;
    int u = qw[0], un = qw[1], p = 0;
    __syncthreads();
    if (u < total) { int a = 0, b = 768; while (b - a > 1) { const int m = (a + b) >> 1; if (pfx[m] <= u) a = m; else b = m; } p = a;
        kv_load(KR, KV + (size_t)((p & 63) * 256) * 1536 + (p >> 6) * 64, KV + (size_t)((p & 63) * 256) * 1536 + 768 + (p >> 6) * 64, 1536, F.tid); }
    while (u < total) {
        int unn = 0;
        if (F.tid == 0) unn = (int)atomicAdd(qctr, 1u);
        const int h = p >> 6, n = p & 63, q0 = (u - pfx[p]) * 512;
        const int cnt = cntl[p];
        const int nq = min(512, cnt - q0);
        kv_write(KR, lds, F.tid);
        __syncthreads();
        int pn = p;
        if (un < total) { int a = 0, b = 768; while (b - a > 1) { const int m = (a + b) >> 1; if (pfx[m] <= un) a = m; else b = m; } pn = a;
            kv_load(KR, KV + (size_t)((pn & 63) * 256) * 1536 + (pn >> 6) * 64, KV + (size_t)((pn & 63) * 256) * 1536 + 768 + (pn >> 6) * 64, 1536, F.tid); }
        const float slope2 = exp2f(-8.0f * (float)(h + 1) / 12.0f) * 1.4426950408889634f;
        const unsigned short* lst = B.list + (size_t)p * 16384 + q0;
        for (int tile = F.wave; 16 * tile < nq; tile += NWAVES) {
            const int qi = 16 * tile + lo; const bool ok = qi < nq;
            const unsigned e = lst[ok ? qi : 0];
            const int t = (int)(e & 0x3fffu), slot = (int)(e >> 14);
            const bf16_t* qp = proj + (size_t)t * 1024 + h * 64;
            const bf16x8 q0f = *(const bf16x8*)(qp + 8 * hi), q1f = *(const bf16x8*)(qp + 32 + 8 * hi);
            f32x4 o[4]; float l = 0.f;
#pragma unroll
            for (int dt = 0; dt < 4; ++dt) o[dt] = (f32x4){0.f, 0.f, 0.f, 0.f};
            attn_core<true, false>(lds, q0f, q1f, 8, slope2, (float)(t - n * 256), lo, hi, o, l);
            l += __shfl_xor(l, 16); l += __shfl_xor(l, 32);
            if (ok) {
                const long long d1 = (const char*)B.slot1 - (const char*)B.slot0, d2 = (const char*)B.slot2 - (const char*)B.slot0;
                bf16_t* sb = (bf16_t*)((char*)B.slot0 + (slot == 1 ? d1 : 0ll) + (slot == 2 ? d2 : 0ll));
                attn_store16(sb + ((size_t)t * 12 + h) * 64 + 16 * hi, o, 1.f);
                if (hi == 0) B.lsl[((size_t)t * 12 + h) * 3 + slot] = l;
            }
        }
        if (F.tid == 0) qw[0] = unn;
        __syncthreads();
        p = pn; u = un; un = qw[0];
    }
}
__device__ __forceinline__ void moba_own(const Frame& F, bf16_t* proj, const bf16_t* KV, const MobaBuf& B) {
    LAS unsigned char* lds = F.lds + RING_OFF;
    const int lane = F.lane, lo = lane & 15, hi = lane >> 4;
    KvRegs KR;
    int u = blockIdx.x;
    if (u < 768) kv_load(KR, KV + (size_t)((u & 63) * 256) * 1536 + (u >> 6) * 64, KV + (size_t)((u & 63) * 256) * 1536 + 768 + (u >> 6) * 64, 1536, F.tid);
    for (; u < 768; u += F.G) {
        const int h = u >> 6, ib = u & 63;
        kv_write(KR, lds, F.tid);
        __syncthreads();
        const int un = u + F.G;
        if (un < 768) kv_load(KR, KV + (size_t)((un & 63) * 256) * 1536 + (un >> 6) * 64, KV + (size_t)((un & 63) * 256) * 1536 + 768 + (un >> 6) * 64, 1536, F.tid);
        const float slope2 = exp2f(-8.0f * (float)(h + 1) / 12.0f) * 1.4426950408889634f;
#pragma unroll 1
        for (int tt = 0; tt < 2; ++tt) {
            const int tile = tt ? 15 - F.wave : F.wave, trel0 = 16 * tile;
            const int t = ib * 256 + trel0 + lo;
            bf16_t* qp = proj + (size_t)t * 1024 + h * 64;
            const bf16x8 q0f = *(const bf16x8*)(qp + 8 * hi), q1f = *(const bf16x8*)(qp + 32 + 8 * hi);
            const int ns = (int)B.nsel[(size_t)t * 12 + h];
            const size_t so = ((size_t)t * 12 + h) * 64 + 16 * hi;
            float ls = 0.f; u32x2 pa[4], pb[4], pc[4];
#pragma unroll
            for (int dt = 0; dt < 4; ++dt) { pa[dt] = (u32x2){0u, 0u}; pb[dt] = pa[dt]; pc[dt] = pa[dt]; }
            if (ns > 0) { ls += B.lsl[((size_t)t * 12 + h) * 3 + 0]; const v4u x = *(const v4u*)(B.slot0 + so), y = *(const v4u*)(B.slot0 + so + 8);
                pa[0] = (u32x2){x.x, x.y}; pa[1] = (u32x2){x.z, x.w}; pa[2] = (u32x2){y.x, y.y}; pa[3] = (u32x2){y.z, y.w}; }
            if (ns > 1) { ls += B.lsl[((size_t)t * 12 + h) * 3 + 1]; const v4u x = *(const v4u*)(B.slot1 + so), y = *(const v4u*)(B.slot1 + so + 8);
                pb[0] = (u32x2){x.x, x.y}; pb[1] = (u32x2){x.z, x.w}; pb[2] = (u32x2){y.x, y.y}; pb[3] = (u32x2){y.z, y.w}; }
            if (ns > 2) { ls += B.lsl[((size_t)t * 12 + h) * 3 + 2]; const v4u x = *(const v4u*)(B.slot2 + so), y = *(const v4u*)(B.slot2 + so + 8);
                pc[0] = (u32x2){x.x, x.y}; pc[1] = (u32x2){x.z, x.w}; pc[2] = (u32x2){y.x, y.y}; pc[3] = (u32x2){y.z, y.w}; }
            f32x4 o[4]; float l = 0.f;
#pragma unroll
            for (int dt = 0; dt < 4; ++dt) o[dt] = (f32x4){0.f, 0.f, 0.f, 0.f};
            const int nkt = tile + 1;
            attn_core<true, true>(lds, q0f, q1f, (nkt + 1) >> 1, slope2, (float)(trel0 + lo), lo, hi, o, l);
            l += __shfl_xor(l, 16); l += __shfl_xor(l, 32);
            l += ls;
#pragma unroll
            for (int dt = 0; dt < 4; ++dt) o[dt] += unpack4(pa[dt]) + unpack4(pb[dt]) + unpack4(pc[dt]);
            const float inv = 1.f / l;
            attn_store16(qp + 16 * hi, o, inv);
        }
        __syncthreads();
    }
}
__device__ __forceinline__ void mem_kv_direct(const Frame& F, const bf16_t* memb, const bf16_t* wmem, const float* rstd, bf16_t* memkv, const float* kgain, int t) {
    const int lane = F.lane, q = lane >> 4, n = lane & 15, row0 = (t & 15) * 16, ct = t >> 4, col0 = ct * 64;
    const bf16_t* ap = memb + (size_t)(row0 + n) * 1024 + 8 * q;
    const bf16_t* bp = wmem + (size_t)(col0 + n) * 1024 + 8 * q;
    f32x4 acc[4] = {{0.f, 0.f, 0.f, 0.f}, {0.f, 0.f, 0.f, 0.f}, {0.f, 0.f, 0.f, 0.f}, {0.f, 0.f, 0.f, 0.f}};
    bf16x8 A0[4], B0[4][4], A1[4], B1[4][4];
#define MKV_LOAD(A_, B_, k0) do { _Pragma("unroll") for (int s_ = 0; s_ < 4; ++s_) { A_[s_] = *(const bf16x8*)(ap + (k0) + 32 * s_); \
    _Pragma("unroll") for (int j_ = 0; j_ < 4; ++j_) B_[s_][j_] = *(const bf16x8*)(bp + (size_t)j_ * 16 * 1024 + (k0) + 32 * s_); } } while (0)
#define MKV_MMA(A_, B_) do { _Pragma("unroll") for (int s_ = 0; s_ < 4; ++s_) _Pragma("unroll") for (int j_ = 0; j_ < 4; ++j_) acc[j_] = MFMA16(A_[s_], B_[s_][j_], acc[j_]); } while (0)
    MKV_LOAD(A0, B0, 0);
#pragma unroll 1
    for (int k0 = 0; k0 < 1024; k0 += 256) {
        MKV_LOAD(A1, B1, k0 + 128);
        MKV_MMA(A0, B0);
        if (k0 + 256 < 1024) MKV_LOAD(A0, B0, k0 + 256);
        MKV_MMA(A1, B1);
    }
#undef MKV_LOAD
#undef MKV_MMA
    float sc[4];
#pragma unroll
    for (int r = 0; r < 4; ++r) sc[r] = rstd[row0 + 4 * q + r];
#pragma unroll
    for (int j = 0; j < 4; ++j)
#pragma unroll
        for (int r = 0; r < 4; ++r) acc[j][r] *= sc[r];
    if ((ct & 4) == 0) {
        const float* g = kgain + (ct >> 3) * 64;
        float ss[4];
#pragma unroll
        for (int r = 0; r < 4; ++r) { ss[r] = 0.f;
#pragma unroll
            for (int j = 0; j < 4; ++j) ss[r] += acc[j][r] * acc[j][r]; }
#pragma unroll
        for (int o = 1; o < 16; o <<= 1)
#pragma unroll
            for (int r = 0; r < 4; ++r) ss[r] += __shfl_xor(ss[r], o);
#pragma unroll
        for (int r = 0; r < 4; ++r) { const float inv = rsqrtf(ss[r] * (1.f / 64.f) + 1e-6f);
#pragma unroll
            for (int j = 0; j < 4; ++j) acc[j][r] *= inv * g[16 * j + n]; }
    }
#pragma unroll
    for (int j = 0; j < 4; ++j)
#pragma unroll
        for (int r = 0; r < 4; ++r) memkv[(size_t)(row0 + 4 * q + r) * 1024 + col0 + 16 * j + n] = f2bf_d(acc[j][r]);
}
__device__ __forceinline__ void mem_knorm_tile(const Frame& F, bf16_t* memkv, int col0, const float* gain) {
    const float g = gain[F.lane];
    for (int r0 = F.wave * 4; r0 < 256; r0 += NWAVES * 4) {
        bf16_t* rowp = memkv + (size_t)r0 * 1024 + col0 + F.lane;
        float v[4][4], ss[4][4];
#pragma unroll
        for (int j = 0; j < 4; ++j)
#pragma unroll
            for (int h = 0; h < 4; ++h) { v[j][h] = bf2f(rowp[(size_t)j * 1024 + h * 64]); ss[j][h] = v[j][h] * v[j][h]; }
#pragma unroll
        for (int o = 1; o < 64; o <<= 1)
#pragma unroll
            for (int j = 0; j < 4; ++j)
#pragma unroll
                for (int h = 0; h < 4; ++h) ss[j][h] += __shfl_xor(ss[j][h], o);
#pragma unroll
        for (int j = 0; j < 4; ++j)
#pragma unroll
            for (int h = 0; h < 4; ++h) rowp[(size_t)j * 1024 + h * 64] = f2bf_d(v[j][h] * rsqrtf(ss[j][h] * (1.f / 64.f) + 1e-6f) * g);
    }
}
#define GRID_BAR() xcd_barrier(bar)
#ifndef PROBE_A
#define PROBE_A -1
#define PROBE_B -1
#define PROBE_SCALE 0.1f
#endif
#define STAMP(i) do { if (PROBE_A >= 0 && blockIdx.x == 0 && threadIdx.x == 0) ((volatile unsigned long long*)(ctl + CW_TS))[i] = __builtin_amdgcn_s_memrealtime(); } while (0)
__global__ void __launch_bounds__(NWAVES * 64, 2) mega_fwd(Args args) {
    extern __shared__ __attribute__((aligned(16))) unsigned char lds_raw[];
    Frame F;
    F.lds = (LAS unsigned char*)lds_raw;
    F.tid = threadIdx.x; F.lane = F.tid & 63; F.wave = __builtin_amdgcn_readfirstlane(F.tid >> 6);
    F.G = gridDim.x; { const int bx = blockIdx.x; F.vcu = (F.G % 8 == 0) ? (bx % 8) * (F.G / 8) + bx / 8 : bx; }
    unsigned char* ws = args.ws;
    gu32* ctl = (gu32*)(ws + WS_CTL);
    for (int u = F.tid; u < (LDS_BYTES - LDSCTL_OFF) / 4; u += NWAVES * 64) ((LAS unsigned*)(F.lds + LDSCTL_OFF))[u] = 0u;
    __syncthreads();
    volatile LAS unsigned* MISC = (volatile LAS unsigned*)(F.lds + MISC_OFF);
    XcdBarrier bar = xcd_barrier_post((unsigned*)(ctl + CW_BAR) + args.bar_region * XCD_BAR_WORDS, MISC + 8);
    STAMP(0);
    const int lo = args.ph_lo, hi = args.ph_hi;
#define IN(k) (lo <= (k) && (k) < hi)
#define BOTH(k) (IN(k) && IN((k) + 1))
    const float* const* in = args.in;
    float* out = args.out;
    bf16_t* XB = (bf16_t*)(ws + WS_XB); bf16_t* BIG = (bf16_t*)(ws + WS_BIG); bf16_t* KVB = (bf16_t*)(ws + WS_KV);
    float* SSQ = (float*)(ws + WS_SSQ);
    const size_t FW = (size_t)1024 * 2752;

    bf16_t* WUP1 = (bf16_t*)(ws + WS_WF1); bf16_t* WDN1 = (bf16_t*)(ws + WS_WF1 + SZ_FFN_UP);
    bf16_t* WUP2 = (bf16_t*)(ws + WS_WF2); bf16_t* WDN2 = (bf16_t*)(ws + WS_WF2 + SZ_FFN_UP);
    bf16_t* MEMKV = (bf16_t*)(ws + WS_MEMKV); bf16_t* MEMB = (bf16_t*)(ws + WS_MEMB); float* RSTDM = (float*)(ws + WS_MEMB + 512 * 1024); float* KMEAN = (float*)(ws + WS_KMEAN); float* KKINV = (float*)(ws + WS_KKINV); float* SBON = (float*)(ws + WS_SBON);
    bf16_t* W2T = (bf16_t*)(ws + WS_SMALLW); bf16_t* A2T = W2T + 768 * 64; bf16_t* G2T = A2T + 768 * 64;
    const RwkvW RW{in[17], in[18], in[20], in[23], in[24], in[25], in[26], in[27], W2T, A2T, G2T};
    const RwkvBuf RB{ws + WS_KV, ws + WS_KV + 24 * MiB, (unsigned char*)out, ws + WS_E, SBON};
    const PG8_LAS float* RT = (F.G == 256) ? (const PG8_LAS float*)(F.lds + RTAB_OFF) : (const PG8_LAS float*)nullptr;
    const int RBASE = 256 * (8 * ((int)blockIdx.x & 7) + (((int)blockIdx.x >> 3) & 7));
#define FILL_RT() do { if (RT) { if (F.tid < 256) { const pg8::f32x4* q_ = (const pg8::f32x4*)(SSQ + (size_t)(RBASE + F.tid) * 16); \
            const pg8::f32x4 a_ = (q_[0] + q_[1]) + (q_[2] + q_[3]); \
            ((LAS float*)(F.lds + RTAB_OFF))[F.tid] = rsqrtf(((a_[0] + a_[1]) + (a_[2] + a_[3])) * (1.0f / 1024.0f) + 1e-6f); } \
        __syncthreads(); } } while (0)
#define GEMM_UP(Aptr, Bptr, Ncols, EPI) do { pg8::Gemm g{Aptr, Bptr, M, Ncols, 1024, 1024}; pg8::StaticOrder S; S.init(M, Ncols, F.G, (int)blockIdx.x); \
        pg8::gemm_phase<decltype(EPI), pg8::StaticOrder, true, true>(F.lds + RING_OFF, g, S, EPI); } while (0)
#define GEMM_DOWN(Bptr, FINAL) do { pg8::Gemm g{BIG, Bptr, M, 1024, FFP, FFP}; pg8::StaticOrder S; S.init(M, 1024, F.G, (int)blockIdx.x); \
        pg8::EpiResid E{XB, SSQ, (FINAL) ? out : nullptr, 0.5f}; pg8::gemm_phase<pg8::EpiResid, pg8::StaticOrder, true, true>(F.lds + RING_OFF, g, S, E); } while (0)
#define GEMM_OUTPROJ(LDA, Bptr) do { pg8::Gemm g{BIG, Bptr, M, 1024, 1024, LDA}; pg8::StaticOrder S; S.init(M, 1024, F.G, (int)blockIdx.x); \
        pg8::EpiResid E{XB, SSQ, nullptr, 1.0f}; pg8::gemm_phase<pg8::EpiResid, pg8::StaticOrder, true, true>(F.lds + RING_OFF, g, S, E); } while (0)

    if (IN(0)) {
        conv_ffn(F, in[2], in[3], in[4], in[5], ws + WS_WF1);
        conv_matrix(F, in[16], 1024, 2816, in[6], (bf16_t*)(ws + WS_WIN1), 1024, 3);
        conv_matrix(F, in[19], 64, 768, nullptr, W2T, 64, 0); conv_matrix(F, in[21], 64, 768, nullptr, A2T, 64, 0); conv_matrix(F, in[22], 128, 768, nullptr, G2T, 128, 0);
        x_to_xb(F, in[0], XB, SSQ, M, false);
        x_to_xb(F, in[1], MEMB, RSTDM, 256, true);
        for (int i = (int)blockIdx.x * NWAVES * 64 + F.tid; i < 12 * 64 * 64; i += (int)F.G * NWAVES * 64) KMEAN[i] = 0.f;
        conv_matrix(F, in[9], 1024, 512, in[8], (bf16_t*)(ws + WS_WMEM), 1024, 0);
        conv_matrix(F, in[9] + (size_t)1024 * 512, 1024, 512, in[8] + 1024, (bf16_t*)(ws + WS_WMEM) + (size_t)512 * 1024, 1024, 0);
        if (BOTH(0)) GRID_BAR(); STAMP(1);
    }
#define TAIL_FILL(NUNITS, BODY) do { const int rem_ = (NUNITS) % F.G; if (rem_ > 0 && (int)blockIdx.x >= rem_) { Frame F2 = F; F2.vcu = (int)blockIdx.x - rem_; F2.G = F.G - rem_; BODY } } while (0)
    if (IN(1)) { FILL_RT(); pg8::EpiUpKV E{BIG, SSQ, nullptr, 0, RT, RBASE, 0, nullptr, nullptr}; GEMM_UP(XB, WUP1, 5632, E);
        TAIL_FILL(64 * 22, { conv_ffn(F2, in[12], in[13], in[14], in[15], ws + WS_WF2); });
        if (BOTH(1)) GRID_BAR(); STAMP(2); }
    if (IN(2)) { GEMM_DOWN(WDN1, false); if (BOTH(2)) GRID_BAR(); STAMP(3); }
    if (IN(3)) { FILL_RT(); pg8::EpiProj E{BIG, 2816, SSQ, RT, RBASE}; GEMM_UP(XB, (const bf16_t*)(ws + WS_WIN1), 2816, E);
        TAIL_FILL(64 * 11, {
            conv_matrix(F2, in[7], 1024, 1024, nullptr, (bf16_t*)(ws + WS_WOUT1), 1024, 0);
            conv_matrix(F2, in[29], 1024, 1536, in[28], (bf16_t*)(ws + WS_WKV), 1024, 4);
            conv_matrix(F2, in[31], 1024, 1024, in[6] + 1024, (bf16_t*)(ws + WS_WIN2), 1024, 0);
            conv_matrix(F2, in[7] + (size_t)1024 * 1024, 1024, 1024, nullptr, (bf16_t*)(ws + WS_WOUT2), 1024, 0); });
        if (BOTH(3)) GRID_BAR(); STAMP(4); }
    if (IN(4)) {
        rwkv_s1(F, BIG, RW, RB);
        if (BOTH(4)) GRID_BAR(); STAMP(5);
    }
    if (IN(5)) {
        rwkv_s2(F, RB);
        if (blockIdx.x >= S2_NWG && blockIdx.x < S2_NWG + 32)
            mem_kv_direct(F, MEMB, (const bf16_t*)(ws + WS_WMEM), RSTDM, MEMKV, in[11], ((int)blockIdx.x - S2_NWG) * 8 + F.wave);
        if (BOTH(5)) GRID_BAR(); STAMP(6); }
    if (IN(6)) { rwkv_s3(F, BIG, RW, RB); __syncthreads(); mem_attn_fast(F, BIG, 2816, 768, in[10], MEMKV); if (BOTH(6)) GRID_BAR(); STAMP(7); }
    if (IN(7)) { GEMM_OUTPROJ(2816, (const bf16_t*)(ws + WS_WOUT1)); if (BOTH(7)) GRID_BAR(); STAMP(8); }
    if (IN(8)) { FILL_RT(); pg8::EpiUpKV E{BIG, SSQ, nullptr, 0, RT, RBASE, 0, nullptr, nullptr}; GEMM_UP(XB, WUP2, 5632, E);
        TAIL_FILL(64 * 22, { conv_ffn(F2, in[2] + 1024, in[3] + FW, in[4] + FW, in[5] + FW, ws + WS_WF1); });
        if (BOTH(8)) GRID_BAR(); STAMP(9); }
    if (IN(9)) { GEMM_DOWN(WDN2, false); if (BOTH(9)) GRID_BAR(); STAMP(10); }
    if (IN(10)) { FILL_RT(); pg8::EpiUpKV E{BIG, SSQ, KVB, 6, RT, RBASE, 3, in[30], KMEAN}; GEMM_UP(XB, (const bf16_t*)(ws + WS_WKV), 7168, E); if (BOTH(10)) GRID_BAR(); STAMP(11); }
    if (IN(11)) { GEMM_DOWN(WDN1, false); if (BOTH(11)) GRID_BAR(); STAMP(12); }
    if (IN(12)) {
        const bool dn_in_tail = (64 * 22) % F.G > 0;
        conv_ffn(F, in[12] + 1024, in[13] + FW, in[14] + FW, in[15] + FW, ws + WS_WF2, dn_in_tail ? 1 : 0);
        __syncthreads();
        FILL_RT(); pg8::EpiProj E{BIG, 1024, SSQ, RT, RBASE}; GEMM_UP(XB, (const bf16_t*)(ws + WS_WIN2), 1024, E);
        if (BOTH(12)) GRID_BAR(); STAMP(13);
    }
    const MobaBuf MB{(unsigned*)(ctl + CW_CNT), (unsigned short*)(ws + WS_BIG + 32 * MiB), ws + WS_KKINV, (bf16_t*)(ws + WS_BIG + 56 * MiB), (bf16_t*)out, (bf16_t*)(ws + WS_E), (float*)(ws + WS_E + 24 * MiB)};
    if (IN(13)) {
        mem_attn_fast(F, BIG, 1024, 768, in[10] + 64, MEMKV + 512);
        __syncthreads(); STAMP(20);
        moba_route(F, BIG, in[32], in[30], KMEAN, MB);
        if (BOTH(13)) GRID_BAR(); STAMP(14);
        moba_selected(F, BIG, KVB, MB);
        GRID_BAR(); STAMP(15);
        moba_own(F, BIG, KVB, MB);
        GRID_BAR(); STAMP(16);
    }
    if (IN(14)) { GEMM_OUTPROJ(1024, (const bf16_t*)(ws + WS_WOUT2)); if (BOTH(14)) GRID_BAR(); STAMP(17); }
    if (IN(15)) { FILL_RT(); pg8::EpiUpKV E{BIG, SSQ, nullptr, 0, RT, RBASE, 0, nullptr, nullptr}; GEMM_UP(XB, WUP2, 5632, E);
        TAIL_FILL(64 * 22, { conv_ffn(F2, in[12] + 1024, in[13] + FW, in[14] + FW, in[15] + FW, ws + WS_WF2, 2); });
        if (BOTH(15)) GRID_BAR(); STAMP(18); }
    if (IN(16)) { GEMM_DOWN(WDN2, true); }
    if (PROBE_A >= 0) { GRID_BAR(); STAMP(19);
        if (blockIdx.x == 0 && threadIdx.x == 0) { volatile unsigned long long* ts = (volatile unsigned long long*)(ctl + CW_TS); const float dt = (float)(ts[PROBE_B] - ts[PROBE_A]) * 0.01f; out[0] += dt * PROBE_SCALE; } }
#undef IN
#undef BOTH
}
}
static int mk_grid = 0;
static bool mk_setup() {
    if (mk_grid != 0) return mk_grid > 0;
    int dev = 0, cus = 0, per_cu = 0;
    if (hipGetDevice(&dev) != hipSuccess || hipDeviceGetAttribute(&cus, hipDeviceAttributeMultiprocessorCount, dev) != hipSuccess) { mk_grid = -1; return false; }
    if (hipFuncSetAttribute((const void*)mk::mega_fwd, hipFuncAttributeMaxDynamicSharedMemorySize, mk::LDS_BYTES) != hipSuccess) { fprintf(stderr, "hipFuncSetAttribute failed\n"); mk_grid = -1; return false; }
    if (hipOccupancyMaxActiveBlocksPerMultiprocessor(&per_cu, (const void*)mk::mega_fwd, mk::NWAVES * 64, mk::LDS_BYTES) != hipSuccess || per_cu < 1) { fprintf(stderr, "occupancy query: %d\n", per_cu); per_cu = 1; }
    (void)hipGetLastError();
    mk_grid = cus * 1;
    return true;
}
static void launch_mega(void* const* d_in, void* d_out, void* d_ws, hipStream_t s, int ph_lo, int ph_hi, int region) {
    if (!mk_setup()) return;
    mk::Args a{};
    for (int i = 0; i < 33; ++i) a.in[i] = (const float*)d_in[i];
    a.out = (float*)d_out; a.ws = (unsigned char*)d_ws; a.ph_lo = ph_lo; a.ph_hi = ph_hi; a.bar_region = region; a.pad = 0;
    void* kargs[] = {&a};
    hipError_t e = hipLaunchCooperativeKernel((const void*)mk::mega_fwd, dim3(mk_grid), dim3(mk::NWAVES * 64), kargs, mk::LDS_BYTES, s);
    if (e != hipSuccess) fprintf(stderr, "cooperative launch failed: %s (grid %d)\n", hipGetErrorString(e), mk_grid);
}
extern "C" void kernel_launch(void* const* d_in, const int* in_sizes, int n_in, void* d_out, int out_size, void* d_ws, size_t ws_size, hipStream_t stream) {
    (void)hipMemsetAsync((char*)d_ws + mk::WS_CTL, 0, mk::CTL_ZERO_BYTES, stream);
    launch_mega(d_in, d_out, d_ws, stream, 0, 17, 0);
}
```
